# Optimizing an MI355X kernel written in HIP

```python
import math
import jax, jax.numpy as jnp
from jax import lax
import numpy as np

D_MODEL = 1024
BATCH = 4
SEQ = 4096
DEPTH = 2
DEC_BATCH = 8
DEC_SEQ = 8192
PAST_LEN = 128

N_MEM = 256
N_MIXERS = 2
N_MLA_LAYERS = (DEPTH + 1) // 2
N_DIFF_LAYERS = DEPTH // 2

MLA_HEADS = 8
MLA_NOPE = 128
MLA_ROPE = 64
MLA_V = 128
Q_LORA = 256
KV_LORA = 256
ROPE_THETA = 10000.0

DIFF_HEADS = 8
DIFF_HD = D_MODEL // DIFF_HEADS // 2
DIFF_VD = 2 * DIFF_HD

XATTN_HEADS = 4
XATTN_HD = D_MODEL // XATTN_HEADS

D_FF = 4 * D_MODEL
N_BUCKETS = 32
MAX_DISTANCE = 128
Q_BLOCK = 128
EPS = 1e-6

kernel_name = 'hybrid_mla_diffattn_encoder'


def rms_norm(x, g):
    xf = x.astype(jnp.float32)
    y = xf * lax.rsqrt(jnp.mean(xf * xf, axis=-1, keepdims=True) + EPS)
    return (y * g.astype(jnp.float32)).astype(x.dtype)


def rope(x, pos):
    half = x.shape[-1] // 2
    freqs = ROPE_THETA ** (-jnp.arange(half, dtype=jnp.float32) / half)
    ang = pos.astype(jnp.float32)[:, None] * freqs[None, :]
    cos = jnp.cos(ang)[:, None, :]
    sin = jnp.sin(ang)[:, None, :]
    xf = x.astype(jnp.float32)
    x1, x2 = xf[..., :half], xf[..., half:]
    return jnp.concatenate([x1 * cos - x2 * sin, x1 * sin + x2 * cos], axis=-1).astype(x.dtype)


def t5_bucket(rel):
    nb = N_BUCKETS // 2
    max_exact = nb // 2
    ret = (rel > 0).astype(jnp.int32) * nb
    n = jnp.abs(rel)
    large = max_exact + (jnp.log(jnp.maximum(n, 1).astype(jnp.float32) / max_exact)
                         / math.log(MAX_DISTANCE / max_exact) * (nb - max_exact)).astype(jnp.int32)
    large = jnp.minimum(large, nb - 1)
    return ret + jnp.where(n < max_exact, n, large)


def sweep_query_blocks(block_fn, *qs):
    b, s = qs[0].shape[:2]
    nb = s // Q_BLOCK
    blocks = tuple(jnp.moveaxis(q.reshape(b, nb, Q_BLOCK, *q.shape[2:]), 1, 0) for q in qs)
    starts = jnp.arange(nb, dtype=jnp.int32) * Q_BLOCK
    out = lax.map(lambda a: block_fn(*a), (starts,) + blocks)
    out = jnp.moveaxis(out, 0, 1)
    return out.reshape(b, s, *out.shape[3:])


def mla_mixer(h, w_in, q_norm, kv_norm, w_uq, w_ukv, w_o):
    b, s, _ = h.shape
    proj = h @ w_in
    c_q, c_kv, k_r = jnp.split(proj, [Q_LORA, Q_LORA + KV_LORA], axis=-1)
    q = (rms_norm(c_q, q_norm) @ w_uq).reshape(b, s, MLA_HEADS, MLA_NOPE + MLA_ROPE)
    kv = (rms_norm(c_kv, kv_norm) @ w_ukv).reshape(b, s, MLA_HEADS, MLA_NOPE + MLA_V)
    q_nope, q_rope = q[..., :MLA_NOPE], q[..., MLA_NOPE:]
    k_nope, v = kv[..., :MLA_NOPE], kv[..., MLA_NOPE:]
    pos = jnp.arange(s, dtype=jnp.int32)
    q_rope = rope(q_rope, pos)
    k_rope = rope(k_r[:, :, None, :], pos)[:, :, 0, :]
    scale = (MLA_NOPE + MLA_ROPE) ** -0.5

    def block(start, qn, qr):
        sc = (jnp.einsum('bqhd,bkhd->bhqk', qn, k_nope)
              + jnp.einsum('bqhr,bkr->bhqk', qr, k_rope)).astype(jnp.float32) * scale
        p = jax.nn.softmax(sc, axis=-1).astype(v.dtype)
        return jnp.einsum('bhqk,bkhd->bqhd', p, v)

    o = sweep_query_blocks(block, q_nope, q_rope)
    return o.reshape(b, s, MLA_HEADS * MLA_V) @ w_o


def diff_mixer(h, layer_idx, rel_bias_table, w_in, lam, subln, w_o):
    b, s, _ = h.shape
    q, k, v = jnp.split(h @ w_in, 3, axis=-1)
    q = q.reshape(b, s, DIFF_HEADS, 2, DIFF_HD)
    k = k.reshape(b, s, DIFF_HEADS, 2, DIFF_HD)
    v = v.reshape(b, s, DIFF_HEADS, DIFF_VD)
    lambda_init = 0.8 - 0.6 * math.exp(-0.3 * layer_idx)
    lf = lam.astype(jnp.float32)
    lam_full = jnp.exp(jnp.sum(lf[0] * lf[1])) - jnp.exp(jnp.sum(lf[2] * lf[3])) + lambda_init
    scale = DIFF_HD ** -0.5
    kpos = jnp.arange(s, dtype=jnp.int32)

    def block(start, qb):
        sc = jnp.einsum('bqhcd,bkhcd->bchqk', qb, k).astype(jnp.float32) * scale
        rel = kpos[None, :] - (start + jnp.arange(Q_BLOCK, dtype=jnp.int32))[:, None]
        bias = jnp.moveaxis(rel_bias_table[t5_bucket(rel)], -1, 0).astype(jnp.float32)
        p = jax.nn.softmax(sc + bias, axis=-1)
        a = (p[:, 0] - lam_full * p[:, 1]).astype(v.dtype)
        return jnp.einsum('bhqk,bkhd->bqhd', a, v)

    o = sweep_query_blocks(block, q)
    o = (rms_norm(o, subln) * (1.0 - lambda_init)).astype(h.dtype)
    return o.reshape(b, s, DIFF_HEADS * DIFF_VD) @ w_o


def memory_cross_attention(h, mem, mem_norm, w_q, w_kv, w_o):
    b, s, _ = h.shape
    m = rms_norm(mem, mem_norm)
    q = (h @ w_q).reshape(b, s, XATTN_HEADS, XATTN_HD)
    k, v = jnp.split(m @ w_kv, 2, axis=-1)
    k = k.reshape(b, N_MEM, XATTN_HEADS, XATTN_HD)
    v = v.reshape(b, N_MEM, XATTN_HEADS, XATTN_HD)
    sc = jnp.einsum('bqhd,bkhd->bhqk', q, k).astype(jnp.float32) * (XATTN_HD ** -0.5)
    p = jax.nn.softmax(sc, axis=-1).astype(v.dtype)
    o = jnp.einsum('bhqk,bkhd->bqhd', p, v).reshape(b, s, D_MODEL)
    return o @ w_o


def squared_relu_mlp(h, w1, w2):
    return jnp.square(jax.nn.relu(h @ w1)) @ w2


def trunk(x, mem, norm_gains, rel_bias_table,
          mla_w_in, mla_q_norm, mla_kv_norm, mla_w_uq, mla_w_ukv, mla_w_o,
          diff_w_in, diff_lambda, diff_subln, diff_w_o,
          xattn_mem_norm, xattn_w_q, xattn_w_kv, xattn_w_o,
          mlp_w1, mlp_w2):
    for i in range(DEPTH):
        g = norm_gains[i]
        j = i // N_MIXERS
        h = rms_norm(x, g[0])
        if i % N_MIXERS == 0:
            h = mla_mixer(h, mla_w_in[j], mla_q_norm[j], mla_kv_norm[j],
                          mla_w_uq[j], mla_w_ukv[j], mla_w_o[j])
        else:
            h = diff_mixer(h, i, rel_bias_table, diff_w_in[j], diff_lambda[j],
                           diff_subln[j], diff_w_o[j])
        x = x + rms_norm(h, g[1])
        h = memory_cross_attention(rms_norm(x, g[2]), mem, xattn_mem_norm[i],
                                   xattn_w_q[i], xattn_w_kv[i], xattn_w_o[i])
        x = x + rms_norm(h, g[3])
        h = squared_relu_mlp(rms_norm(x, g[4]), mlp_w1[i], mlp_w2[i])
        x = x + rms_norm(h, g[5])
    return x


def setup_inputs(seed: int = 0) -> dict:
    key = jax.random.key(seed)
    ks = jax.random.split(key, 24)
    f32 = jnp.float32

    def w(k, shape, fan_in):
        return jax.random.normal(k, shape, f32) * (fan_in ** -0.5)

    def gain(k, shape):
        return 1.0 + 0.01 * jax.random.normal(k, shape, f32)

    na, nd = N_MLA_LAYERS, N_DIFF_LAYERS
    return {
        'x_prompt': jax.random.normal(ks[0], (BATCH, SEQ, D_MODEL), f32),
        'x_sample': jax.random.normal(ks[1], (DEC_BATCH, DEC_SEQ, D_MODEL), f32),
        'mem_prompt': jax.random.normal(ks[2], (BATCH, N_MEM, D_MODEL), f32),
        'mem_sample': jax.random.normal(ks[3], (DEC_BATCH, N_MEM, D_MODEL), f32),
        'norm_gains': gain(ks[4], (DEPTH, 6, D_MODEL)),
        'rel_bias_table': 0.1 * jax.random.normal(ks[5], (N_BUCKETS, DIFF_HEADS), f32),
        'mla_w_in': w(ks[6], (na, D_MODEL, Q_LORA + KV_LORA + MLA_ROPE), D_MODEL),
        'mla_q_norm': gain(ks[7], (na, Q_LORA)),
        'mla_kv_norm': gain(ks[8], (na, KV_LORA)),
        'mla_w_uq': w(ks[9], (na, Q_LORA, MLA_HEADS * (MLA_NOPE + MLA_ROPE)), Q_LORA),
        'mla_w_ukv': w(ks[10], (na, KV_LORA, MLA_HEADS * (MLA_NOPE + MLA_V)), KV_LORA),
        'mla_w_o': w(ks[11], (na, MLA_HEADS * MLA_V, D_MODEL), MLA_HEADS * MLA_V),
        'diff_w_in': w(ks[12], (nd, D_MODEL, 3 * D_MODEL), D_MODEL),
        'diff_lambda': 0.1 * jax.random.normal(ks[13], (nd, 4, DIFF_HD), f32),
        'diff_subln': gain(ks[14], (nd, DIFF_VD)),
        'diff_w_o': w(ks[15], (nd, DIFF_HEADS * DIFF_VD, D_MODEL), DIFF_HEADS * DIFF_VD),
        'xattn_mem_norm': gain(ks[16], (DEPTH, D_MODEL)),
        'xattn_w_q': w(ks[17], (DEPTH, D_MODEL, D_MODEL), D_MODEL),
        'xattn_w_kv': w(ks[18], (DEPTH, D_MODEL, 2 * D_MODEL), D_MODEL),
        'xattn_w_o': w(ks[19], (DEPTH, D_MODEL, D_MODEL), D_MODEL),
        'mlp_w1': w(ks[20], (DEPTH, D_MODEL, D_FF), D_MODEL),
        'mlp_w2': w(ks[21], (DEPTH, D_FF, D_MODEL), D_FF),
    }


def reference(x_prompt, x_sample, mem_prompt, mem_sample, norm_gains, rel_bias_table,
              mla_w_in, mla_q_norm, mla_kv_norm, mla_w_uq, mla_w_ukv, mla_w_o,
              diff_w_in, diff_lambda, diff_subln, diff_w_o,
              xattn_mem_norm, xattn_w_q, xattn_w_kv, xattn_w_o,
              mlp_w1, mlp_w2):
    y_prompt = trunk(x_prompt, mem_prompt, norm_gains, rel_bias_table,
                     mla_w_in, mla_q_norm, mla_kv_norm, mla_w_uq, mla_w_ukv, mla_w_o,
                     diff_w_in, diff_lambda, diff_subln, diff_w_o,
                     xattn_mem_norm, xattn_w_q, xattn_w_kv, xattn_w_o,
                     mlp_w1, mlp_w2)
    y_sample = trunk(x_sample, mem_sample, norm_gains, rel_bias_table,
                     mla_w_in, mla_q_norm, mla_kv_norm, mla_w_uq, mla_w_ukv, mla_w_o,
                     diff_w_in, diff_lambda, diff_subln, diff_w_o,
                     xattn_mem_norm, xattn_w_q, xattn_w_kv, xattn_w_o,
                     mlp_w1, mlp_w2)
    return (y_prompt, y_sample)
```

```cpp
#include <hip/hip_runtime.h>
#include <hip/hip_cooperative_groups.h>
#include <cstdio>
#include <cstdint>
namespace cg = cooperative_groups;
namespace pg8 {
#define PG8_LAS __attribute__((address_space(3)))
typedef unsigned short bf16_t;
typedef short bf16x8 __attribute__((ext_vector_type(8)));
typedef float f32x4 __attribute__((ext_vector_type(4)));
typedef unsigned u32x4 __attribute__((ext_vector_type(4)));
constexpr int BM = 256, BK = 64, HALF = 128, HTB = HALF * BK * 2  , STAGE_BYTES = 8 * HTB, NXCD = 8, WGM = 8;

__host__ __device__ __forceinline__ int lds_byte(int r, int c) { const int st = (r >> 4) * 2 + (c >> 5), rr = r & 15, cc = c & 31, ob = rr * 64 + cc * 2; return st * 1024 + (ob ^ (((ob >> 9) & 1) << 5)); }
__host__ __device__ __forceinline__ void stage_rc(int b, int& R, int& C) { const int st = b / 1024, sb = b % 1024, swz = sb ^ (((sb >> 9) & 1) << 5); R = (st >> 1) * 16 + swz / 64; C = (st & 1) * 32 + (swz % 64) / 2; }
__host__ __device__ __forceinline__ int perm32(int rho) { const int n = rho >> 4, i = rho & 15; return 8 * (i >> 2) + 4 * n + (i & 3); }

struct Unit { int pm, pn; };
struct Gemm { const bf16_t* A; const bf16_t* Bt; int M, N, K; };

struct StaticOrder {
    int nM, nN, nwg, G, c;
    __host__ __device__ void init(int M, int N, int G_, int c_) { nM = M / BM; nN = N / BM; nwg = nM * nN; G = G_; c = c_; }
    __host__ __device__ bool next(int i, Unit& u) const {
        const long L = (long)i * G + c; if (L >= nwg) return false;
        int wgid = (int)L; { const int q = nwg / NXCD, r = nwg % NXCD, xcd = wgid % NXCD, off = wgid / NXCD; wgid = (xcd < r ? xcd * (q + 1) : r * (q + 1) + (xcd - r) * q) + off; }
        const int nig = WGM * nN, gid = wgid / nig, fm = gid * WGM, gsz = (nM - fm) < WGM ? (nM - fm) : WGM;
        u.pm = fm + ((wgid % nig) % gsz); u.pn = (wgid % nig) / gsz; return true;
    }
    __device__ __forceinline__ void a_ready(const Unit&) const {}
    __device__ __forceinline__ void done(const Unit&) const {}
};

__device__ __forceinline__ unsigned cvt_pk_bf16(float lo, float hi) { unsigned r; asm volatile("v_cvt_pk_bf16_f32 %0, %1, %2" : "=v"(r) : "v"(lo), "v"(hi)); return r; }
typedef float f32x2 __attribute__((ext_vector_type(2)));
struct EpiRt {
    static constexpr bool PERM = true, AFTER_DRAIN = false;
    bf16_t* O; int ldc; int act;
    __device__ __forceinline__ void operator()(const f32x4 (&acc)[2][2][4][2], const Unit& u, int wr, int wc, int fr, int fq) const {
        const int row0 = u.pm * BM + wr * 64 + fr; const int col0 = u.pn * BM + wc * 32 + 8 * fq;
#pragma unroll
        for (int ai = 0; ai < 2; ++ai)
#pragma unroll
            for (int m = 0; m < 4; ++m) { bf16_t* rowp = O + (size_t)(row0 + ai * HALF + m * 16) * ldc + col0;
#pragma unroll
                for (int bj = 0; bj < 2; ++bj) { f32x4 v0 = acc[ai][bj][m][0], v1 = acc[ai][bj][m][1];
                    if (act) {
#pragma unroll
                        for (int e = 0; e < 4; ++e) { float a = fmaxf(v0[e], 0.f), b = fmaxf(v1[e], 0.f); v0[e] = a * a; v1[e] = b * b; } }
                    u32x4 w; w.x = cvt_pk_bf16(v0[0], v0[1]); w.y = cvt_pk_bf16(v0[2], v0[3]); w.z = cvt_pk_bf16(v1[0], v1[1]); w.w = cvt_pk_bf16(v1[2], v1[3]);
                    *(u32x4*)(rowp + bj * HALF) = w; } }
    }
};
template <class Epi, class Sched, bool ALIGN_EPI = false, bool SP2 = false>
__device__ __forceinline__ void gemm_phase(PG8_LAS unsigned char* lds, const Gemm g, const Sched& S, const Epi& E) {
    int tid_ = threadIdx.x; asm volatile("" : "+v"(tid_)); const int tid = tid_, wid = __builtin_amdgcn_readfirstlane(tid >> 6), lane = tid & 63, wr = wid >> 2, wc = wid & 3, fr = lane & 15, fq = lane >> 4;
    const int K = g.K, nt = K / BK;
    unsigned voffA[2], voffB[2];
#pragma unroll
    for (int i = 0; i < 2; ++i) { int R, C; stage_rc(tid * 16 + i * 8192, R, C); const int Rb = Epi::PERM ? ((R & ~31) + perm32(R & 31)) : R;
        voffA[i] = (unsigned)(R * K + C) * 2u; voffB[i] = (unsigned)(Rb * K + C) * 2u; }
    const size_t kstep = (size_t)(BK * 2);
    const size_t hstep = (size_t)HALF * K * 2;
    const size_t tstep = 2 * hstep;
    const unsigned ldsw = (unsigned)wid * 1024u;
    const int aoff = lds_byte(wr * 64 + fr, fq * 8), boff = lds_byte(wc * 32 + fr, fq * 8);
#define PG8_SA(b, h) (((b) * 2 + (h)) * HTB)
#define PG8_SB(b, h) ((4 + (b) * 2 + (h)) * HTB)
#define PG8_STAGE(bufoff, gbase, voff) do { _Pragma("unroll") for (int _i = 0; _i < 2; ++_i) \
        __builtin_amdgcn_global_load_lds((const unsigned*)((const char*)(gbase) + (voff)[_i]), (PG8_LAS unsigned*)(lds + (bufoff) + ldsw + _i * 8192), 16, 0, 0); } while (0)
#define PG8_LDA(dst, b, h) do { _Pragma("unroll") for (int m = 0; m < 4; ++m) _Pragma("unroll") for (int k = 0; k < 2; ++k) dst[m][k] = *(const PG8_LAS bf16x8*)(lds + PG8_SA(b, h) + aoff + m * 2048 + k * 1024); } while (0)
#define PG8_LDB(dst, b, h) do { _Pragma("unroll") for (int n = 0; n < 2; ++n) _Pragma("unroll") for (int k = 0; k < 2; ++k) dst[n][k] = *(const PG8_LAS bf16x8*)(lds + PG8_SB(b, h) + boff + n * 2048 + k * 1024); } while (0)
#define PG8_MMA(ai, bj, At, Bt) do { __builtin_amdgcn_s_setprio(1); _Pragma("unroll") for (int m = 0; m < 4; ++m) _Pragma("unroll") for (int n = 0; n < 2; ++n) _Pragma("unroll") for (int k = 0; k < 2; ++k) \
        acc[ai][bj][m][n] = __builtin_amdgcn_mfma_f32_16x16x32_bf16(Bt[n][k], At[m][k], acc[ai][bj][m][n], 0, 0, 0); __builtin_amdgcn_s_setprio(0); } while (0)
#define PG8_WAIT_V(n) asm volatile("s_waitcnt vmcnt(" #n ")" ::: "memory")
#define PG8_WAIT_L(n) asm volatile("s_waitcnt lgkmcnt(" #n ")" ::: "memory")
#define PG8_BAR __builtin_amdgcn_s_barrier()
#define PG8_SCHED __builtin_amdgcn_sched_barrier(0)
    Unit cur, nxt; int ui = 0;
    if (!S.next(0, cur)) return;
    f32x4 acc[2][2][4][2];
#pragma unroll
    for (int a = 0; a < 2; ++a)
#pragma unroll
        for (int b = 0; b < 2; ++b)
#pragma unroll
            for (int m = 0; m < 4; ++m)
#pragma unroll
                for (int n = 0; n < 2; ++n) acc[a][b][m][n] = (f32x4){0.f, 0.f, 0.f, 0.f};
    bf16x8 At[4][2], B0[2][2], B1[2][2];
    const char* cA = (const char*)g.A + (size_t)cur.pm * tstep; const char* cB = (const char*)g.Bt + (size_t)cur.pn * tstep;
    S.a_ready(cur);
    if constexpr (SP2) {
        PG8_STAGE(PG8_SB(0, 0), cB, voffB); PG8_STAGE(PG8_SB(0, 1), cB + hstep, voffB); PG8_STAGE(PG8_SA(0, 0), cA, voffA); PG8_STAGE(PG8_SA(0, 1), cA + hstep, voffA);
        if (wr == 1) PG8_BAR;
        PG8_WAIT_V(2); PG8_BAR;
        PG8_STAGE(PG8_SB(1, 0), cB + kstep, voffB); PG8_STAGE(PG8_SA(1, 0), cA + kstep, voffA); PG8_STAGE(PG8_SB(1, 1), cB + hstep + kstep, voffB);
        PG8_WAIT_V(6); PG8_BAR;
    } else {
        PG8_STAGE(PG8_SB(0, 0), cB, voffB); PG8_STAGE(PG8_SA(0, 0), cA, voffA); PG8_STAGE(PG8_SB(0, 1), cB + hstep, voffB); PG8_STAGE(PG8_SA(0, 1), cA + hstep, voffA);
        if (wr == 1) PG8_BAR;
        PG8_WAIT_V(4); PG8_BAR;
        PG8_STAGE(PG8_SB(1, 0), cB + kstep, voffB); PG8_STAGE(PG8_SA(1, 0), cA + kstep, voffA); PG8_STAGE(PG8_SB(1, 1), cB + hstep + kstep, voffB);
        PG8_WAIT_V(6); PG8_BAR;
    }
    for (;;) {
        const bool has_next = S.next(ui + 1, nxt);
        const char* nA = has_next ? (const char*)g.A + (size_t)nxt.pm * tstep : cA; const char* nB = has_next ? (const char*)g.Bt + (size_t)nxt.pn * tstep : cB;
        for (int t = 0; t < nt; t += 2) {
            const bool last = (t == nt - 2);
            const char* a1 = cA + (size_t)(t + 1) * kstep;
            const char* a2 = last ? nA : cA + (size_t)(t + 2) * kstep; const char* b2 = last ? nB : cB + (size_t)(t + 2) * kstep;
            const char* a3 = a2 + kstep; const char* b3 = b2 + kstep;
            if (last && has_next) S.a_ready(nxt);
            if constexpr (SP2) {
            PG8_LDB(B0, 0, 0); PG8_LDB(B1, 0, 1); PG8_SCHED; PG8_LDA(At, 0, 0); PG8_STAGE(PG8_SA(1, 1), a1 + hstep, voffA);
            PG8_WAIT_V(8); PG8_WAIT_L(0); PG8_BAR; PG8_MMA(0, 0, At, B0); PG8_MMA(0, 1, At, B1); PG8_BAR; PG8_SCHED;
            PG8_LDA(At, 0, 1); PG8_STAGE(PG8_SB(0, 0), b2, voffB); PG8_STAGE(PG8_SB(0, 1), b2 + hstep, voffB); PG8_STAGE(PG8_SA(0, 0), a2, voffA);
            PG8_WAIT_V(8); PG8_WAIT_L(0); PG8_BAR; PG8_MMA(1, 0, At, B0); PG8_MMA(1, 1, At, B1); PG8_BAR; PG8_SCHED;
            PG8_LDB(B0, 1, 0); PG8_LDB(B1, 1, 1); PG8_SCHED; PG8_LDA(At, 1, 0); PG8_STAGE(PG8_SA(0, 1), a2 + hstep, voffA);
            PG8_WAIT_V(8); PG8_WAIT_L(0); PG8_BAR; PG8_MMA(0, 0, At, B0); PG8_MMA(0, 1, At, B1); PG8_BAR; PG8_SCHED;
            PG8_LDA(At, 1, 1); PG8_STAGE(PG8_SB(1, 0), b3, voffB); PG8_STAGE(PG8_SB(1, 1), b3 + hstep, voffB); PG8_STAGE(PG8_SA(1, 0), a3, voffA);
            PG8_WAIT_V(8); PG8_WAIT_L(0); PG8_BAR; PG8_MMA(1, 0, At, B0); PG8_MMA(1, 1, At, B1); PG8_BAR; PG8_SCHED;
            } else {
            PG8_LDB(B0, 0, 0); PG8_SCHED; PG8_LDA(At, 0, 0); PG8_STAGE(PG8_SA(1, 1), a1 + hstep, voffA);
            PG8_WAIT_L(8); PG8_BAR; PG8_WAIT_L(0); PG8_MMA(0, 0, At, B0); PG8_BAR; PG8_SCHED;
            PG8_LDB(B1, 0, 1); PG8_STAGE(PG8_SB(0, 0), b2, voffB);
            PG8_BAR; PG8_WAIT_L(0); PG8_MMA(0, 1, At, B1); PG8_BAR;
            PG8_LDA(At, 0, 1); PG8_STAGE(PG8_SA(0, 0), a2, voffA);
            PG8_BAR; PG8_WAIT_L(0); PG8_MMA(1, 0, At, B0); PG8_BAR; PG8_SCHED;
            PG8_STAGE(PG8_SB(0, 1), b2 + hstep, voffB);
            PG8_WAIT_V(6); PG8_BAR; PG8_MMA(1, 1, At, B1); PG8_BAR;
            PG8_LDB(B0, 1, 0); PG8_SCHED; PG8_LDA(At, 1, 0); PG8_STAGE(PG8_SA(0, 1), a2 + hstep, voffA);
            PG8_WAIT_L(8); PG8_BAR; PG8_WAIT_L(0); PG8_MMA(0, 0, At, B0); PG8_BAR; PG8_SCHED;
            PG8_LDB(B1, 1, 1); PG8_STAGE(PG8_SB(1, 0), b3, voffB);
            PG8_BAR; PG8_WAIT_L(0); PG8_MMA(0, 1, At, B1); PG8_BAR;
            PG8_LDA(At, 1, 1); PG8_STAGE(PG8_SA(1, 0), a3, voffA);
            PG8_BAR; PG8_WAIT_L(0); PG8_MMA(1, 0, At, B0); PG8_BAR; PG8_SCHED;
            PG8_STAGE(PG8_SB(1, 1), b3 + hstep, voffB);
            PG8_WAIT_V(6); PG8_BAR; PG8_MMA(1, 1, At, B1); PG8_BAR;
            }
        }
        if constexpr (ALIGN_EPI) { if (wr == 0) PG8_BAR; }
        if constexpr (!Epi::AFTER_DRAIN) { E(acc, cur, wr, wc, fr, fq); S.done(cur); }
        if (!has_next) break;
#pragma unroll
        for (int a = 0; a < 2; ++a)
#pragma unroll
            for (int b = 0; b < 2; ++b)
#pragma unroll
                for (int m = 0; m < 4; ++m)
#pragma unroll
                    for (int n = 0; n < 2; ++n) acc[a][b][m][n] = (f32x4){0.f, 0.f, 0.f, 0.f};
        cur = nxt; cA = nA; cB = nB; ++ui;
        if constexpr (ALIGN_EPI) { if (wr == 1) PG8_BAR; }
    }
    PG8_WAIT_V(0);
    if constexpr (!ALIGN_EPI) { if (wr == 0) PG8_BAR; }
    PG8_BAR;
    if constexpr (Epi::AFTER_DRAIN) { E.fused(acc, cur, wr, wc, fr, fq, lds, wid, lane); S.done(cur); }
#undef PG8_SA
#undef PG8_SB
#undef PG8_STAGE
#undef PG8_LDA
#undef PG8_LDB
#undef PG8_MMA
#undef PG8_WAIT_V
#undef PG8_WAIT_L
#undef PG8_BAR
#undef PG8_SCHED
}
}

#define LAS __attribute__((address_space(3)))
typedef unsigned short bf16_t;
typedef short bf16x8 __attribute__((ext_vector_type(8)));
typedef short s16x4 __attribute__((ext_vector_type(4)));
typedef float f32x4 __attribute__((ext_vector_type(4)));
typedef float f32x16 __attribute__((ext_vector_type(16)));
typedef unsigned u32x4 __attribute__((ext_vector_type(4)));
typedef unsigned u32x2 __attribute__((ext_vector_type(2)));

#ifndef NPH_LIMIT
#define NPH_LIMIT 25
#endif

constexpr int DM = 1024, MP = 4 * 4096, MS = 8 * 8192, MT = MP + MS;
constexpr int SP = 4096, SS = 8192;
constexpr int NMR = 12 * 256;
constexpr float EPS = 1e-6f, LOG2E = 1.4426950408889634f;
constexpr float LAMBDA_INIT = 0.35550906759f;

constexpr size_t MiB = 1u << 20;
constexpr size_t O_COS = 1 * MiB, O_SIN = 2 * MiB;
constexpr size_t O_W_MLA_IN = 3 * MiB;
constexpr size_t O_W_MLA_UQ = O_W_MLA_IN + 2 * MiB;
constexpr size_t O_W_MLA_UKV = O_W_MLA_UQ + 1 * MiB;
constexpr size_t O_W_MLA_O = O_W_MLA_UKV + 1 * MiB;
constexpr size_t O_W_DIFF_IN = O_W_MLA_O + 2 * MiB;
constexpr size_t O_W_DIFF_O = O_W_DIFF_IN + 6 * MiB;
constexpr size_t O_W_XQ = O_W_DIFF_O + 2 * MiB;
constexpr size_t O_W_XKV = O_W_XQ + 4 * MiB;
constexpr size_t O_W_XO = O_W_XKV + 8 * MiB;
constexpr size_t O_W_1 = O_W_XO + 4 * MiB;
constexpr size_t O_W_2 = O_W_1 + 16 * MiB;
constexpr size_t O_MEMN = O_W_2 + 16 * MiB;
constexpr size_t O_MKV = O_MEMN + 12 * MiB;
constexpr size_t A0 = 104 * MiB;
static_assert(O_MKV + 24 * MiB <= A0, "fixed region");
constexpr size_t O_XH = A0;
constexpr size_t O_CNKV = A0, O_KR = A0 + 40 * MiB;
constexpr size_t O_O = A0 + 160 * MiB;
constexpr size_t O_C = O_O, O_CNQ = O_O + 120 * MiB;
constexpr size_t O_ACT = A0 + 160 * MiB;
constexpr size_t O_BR = A0 + 320 * MiB;
constexpr size_t O_Q = O_BR, O_KV = O_BR + 240 * MiB, O_XQ = O_BR, O_QKV = O_BR;
constexpr size_t WS_END = A0 + 880 * MiB;
static_assert(WS_END <= 1024 * MiB, "workspace");

constexpr int LDS_BYTES = 131072 + 4096;

struct Params { const float* in[22]; float* out; unsigned char* ws; };

__device__ __forceinline__ unsigned cvtpk(float lo, float hi) { unsigned r; asm volatile("v_cvt_pk_bf16_f32 %0, %1, %2" : "=v"(r) : "v"(lo), "v"(hi)); return r; }
__device__ __forceinline__ int otid() { int t = threadIdx.x; asm volatile("" : "+v"(t)); return t; }
__device__ __forceinline__ float bflo(unsigned w) { return __uint_as_float(w << 16); }
__device__ __forceinline__ float bfhi(unsigned w) { return __uint_as_float(w & 0xffff0000u); }
__device__ __forceinline__ float bf1(short s) { return __uint_as_float(((unsigned)(unsigned short)s) << 16); }
__device__ __forceinline__ float wave_sum(float v) {
#pragma unroll
    for (int o = 1; o < 64; o <<= 1) v += __shfl_xor(v, o);
    return v;
}
__device__ __forceinline__ int tok_pos(int row) { return row < MP ? (row & (SP - 1)) : ((row - MP) & (SS - 1)); }

__device__ __forceinline__ void transpose_item(const float* __restrict__ W, int K, int N, bf16_t* __restrict__ WT, LAS float* scr, int item, int lane) {
    const int nblk = N / 32, kb = item / nblk, nb = item % nblk, k0 = 64 * kb, n0 = 32 * nb;
#pragma unroll 8
    for (int i = 0; i < 32; ++i) { const int kk = 2 * i + (lane >> 5); scr[kk * 33 + (lane & 31)] = W[(size_t)(k0 + kk) * N + n0 + (lane & 31)]; }
    asm volatile("s_waitcnt lgkmcnt(0)" ::: "memory");
    const int c = lane & 7;
#pragma unroll
    for (int j = 0; j < 4; ++j) { const int n = (lane >> 3) + 8 * j; const LAS float* s = scr + (8 * c) * 33 + n;
        u32x4 o; o.x = cvtpk(s[0 * 33], s[1 * 33]); o.y = cvtpk(s[2 * 33], s[3 * 33]); o.z = cvtpk(s[4 * 33], s[5 * 33]); o.w = cvtpk(s[6 * 33], s[7 * 33]);
        *(u32x4*)(WT + (size_t)(n0 + n) * K + k0 + 8 * c) = o; }
    asm volatile("s_waitcnt lgkmcnt(0)" ::: "memory");
}

__device__ __forceinline__ void norm_store_row(const f32x4 (&v)[4], const float* __restrict__ g, bf16_t* __restrict__ orow, int lane) {
    float s = 0.f;
#pragma unroll
    for (int j = 0; j < 4; ++j) s += (v[j].x * v[j].x + v[j].y * v[j].y) + (v[j].z * v[j].z + v[j].w * v[j].w);
    s = wave_sum(s);
    const float rs = 1.0f / sqrtf(s * (1.f / 1024.f) + EPS);
#pragma unroll
    for (int j = 0; j < 4; ++j) { const f32x4 gg = *(const f32x4*)(g + 4 * lane + 256 * j);
        u32x2 w; w.x = cvtpk(v[j].x * rs * gg.x, v[j].y * rs * gg.y); w.y = cvtpk(v[j].z * rs * gg.z, v[j].w * rs * gg.w);
        *(u32x2*)(orow + 4 * lane + 256 * j) = w; }
}

__device__ __forceinline__ void phase_prologue(const Params& P, LAS unsigned char* lds, int gw, int NGW, int wave, int lane) {
    unsigned char* ws = P.ws;
    LAS float* scr = (LAS float*)(lds + wave * 16384);
    {
        constexpr int I0 = (1024 / 64) * (576 / 32), I1 = (256 / 64) * (1536 / 32), I2 = (256 / 64) * (2048 / 32), I3 = (1024 / 64) * (1024 / 32),
                      I4 = (1024 / 64) * (3072 / 32), I5 = I3, I6 = I3, I7 = (1024 / 64) * (2048 / 32), I8 = I3, I9 = (1024 / 64) * (4096 / 32), I10 = (4096 / 64) * (1024 / 32);
        constexpr int NIT = I0 + I1 + I2 + I3 + I4 + I5 + 2 * I6 + 2 * I7 + 2 * I8 + 2 * I9 + 2 * I10;
        for (int it = gw; it < NIT; it += NGW) {
            int r = it;
#define TJ(CNT, SRC, KK, NN, DST) if (r < (CNT)) { transpose_item((SRC), (KK), (NN), (bf16_t*)(ws + (DST)), scr, r, lane); continue; } r -= (CNT);
            TJ(I0, P.in[6], 1024, 576, O_W_MLA_IN)
            TJ(I1, P.in[9], 256, 1536, O_W_MLA_UQ)
            TJ(I2, P.in[10], 256, 2048, O_W_MLA_UKV)
            TJ(I3, P.in[11], 1024, 1024, O_W_MLA_O)
            TJ(I4, P.in[12], 1024, 3072, O_W_DIFF_IN)
            TJ(I5, P.in[15], 1024, 1024, O_W_DIFF_O)
            TJ(I6, P.in[17], 1024, 1024, O_W_XQ)
            TJ(I6, P.in[17] + 1024 * 1024, 1024, 1024, O_W_XQ + 2 * MiB)
            TJ(I7, P.in[18], 1024, 2048, O_W_XKV)
            TJ(I7, P.in[18] + 1024 * 2048, 1024, 2048, O_W_XKV + 4 * MiB)
            TJ(I8, P.in[19], 1024, 1024, O_W_XO)
            TJ(I8, P.in[19] + 1024 * 1024, 1024, 1024, O_W_XO + 2 * MiB)
            TJ(I9, P.in[20], 1024, 4096, O_W_1)
            TJ(I9, P.in[20] + 1024 * 4096, 1024, 4096, O_W_1 + 8 * MiB)
            TJ(I10, P.in[21], 4096, 1024, O_W_2)
            TJ(I10, P.in[21] + 4096 * 1024, 4096, 1024, O_W_2 + 8 * MiB)
#undef TJ
        }
    }
    {
        float* cosT = (float*)(ws + O_COS); float* sinT = (float*)(ws + O_SIN);
        for (int idx = gw * 64 + lane; idx < 8192 * 32; idx += NGW * 64) {
            const int pos = idx >> 5, i = idx & 31;
            const float fr = exp2f(-(float)i * (13.287712379549449f / 32.f));
            const float ang = (float)pos * fr;
            cosT[idx] = cosf(ang); sinT[idx] = sinf(ang);
        }
    }
    for (int r = gw; r < 2 * NMR; r += NGW) {
        const int li = r / NMR, rr = r % NMR;
        const float* src = rr < 1024 ? P.in[2] + (size_t)rr * DM : P.in[3] + (size_t)(rr - 1024) * DM;
        f32x4 v[4];
#pragma unroll
        for (int j = 0; j < 4; ++j) v[j] = *(const f32x4*)(src + 4 * lane + 256 * j);
        norm_store_row(v, P.in[16] + li * DM, (bf16_t*)(ws + O_MEMN) + (size_t)r * DM, lane);
    }
    for (int r = gw; r < MT; r += NGW) {
        const float* src = r < MP ? P.in[0] + (size_t)r * DM : P.in[1] + (size_t)(r - MP) * DM;
        f32x4 v[4];
#pragma unroll
        for (int j = 0; j < 4; ++j) v[j] = *(const f32x4*)(src + 4 * lane + 256 * j);
#pragma unroll
        for (int j = 0; j < 4; ++j) *(f32x4*)(P.out + (size_t)r * DM + 4 * lane + 256 * j) = v[j];
        norm_store_row(v, P.in[4], (bf16_t*)(ws + O_XH) + (size_t)r * DM, lane);
    }
}

__device__ __forceinline__ void phase_resnorm(const Params& P, const float* __restrict__ ga, const float* __restrict__ gb, int gw, int NGW, int lane) {
    bf16_t* H = (bf16_t*)(P.ws + O_XH);
    for (int r = gw; r < MT; r += NGW) {
        f32x4 h[4], x[4]; float s = 0.f;
#pragma unroll
        for (int j = 0; j < 4; ++j) { const u32x2 w = *(const u32x2*)(H + (size_t)r * DM + 4 * lane + 256 * j);
            h[j] = (f32x4){bflo(w.x), bfhi(w.x), bflo(w.y), bfhi(w.y)};
            x[j] = *(const f32x4*)(P.out + (size_t)r * DM + 4 * lane + 256 * j);
            s += (h[j].x * h[j].x + h[j].y * h[j].y) + (h[j].z * h[j].z + h[j].w * h[j].w); }
        s = wave_sum(s);
        const float rs = 1.0f / sqrtf(s * (1.f / 1024.f) + EPS);
#pragma unroll
        for (int j = 0; j < 4; ++j) { const f32x4 gg = *(const f32x4*)(ga + 4 * lane + 256 * j);
            x[j] = x[j] + h[j] * rs * gg;
            *(f32x4*)(P.out + (size_t)r * DM + 4 * lane + 256 * j) = x[j]; }
        if (gb) norm_store_row(x, gb, H + (size_t)r * DM, lane);
    }
}

__device__ __forceinline__ void phase_cnorm(const Params& P, int gw, int NGW, int lane) {
    const bf16_t* C = (const bf16_t*)(P.ws + O_C);
    bf16_t* CNQ = (bf16_t*)(P.ws + O_CNQ); bf16_t* CNKV = (bf16_t*)(P.ws + O_CNKV); bf16_t* KR = (bf16_t*)(P.ws + O_KR);
    const float* cosT = (const float*)(P.ws + O_COS); const float* sinT = (const float*)(P.ws + O_SIN);
    const f32x4 gq = *(const f32x4*)(P.in[7] + 4 * lane), gk = *(const f32x4*)(P.in[8] + 4 * lane);
    for (int r = gw; r < MT; r += NGW) {
        const bf16_t* c = C + (size_t)r * 768;
        const u32x2 a = *(const u32x2*)(c + 4 * lane), b = *(const u32x2*)(c + 256 + 4 * lane);
        const float kr = __uint_as_float(((unsigned)c[512 + lane]) << 16);
        const f32x4 va = {bflo(a.x), bfhi(a.x), bflo(a.y), bfhi(a.y)}, vb = {bflo(b.x), bfhi(b.x), bflo(b.y), bfhi(b.y)};
        float sa = (va.x * va.x + va.y * va.y) + (va.z * va.z + va.w * va.w), sb = (vb.x * vb.x + vb.y * vb.y) + (vb.z * vb.z + vb.w * vb.w);
        sa = wave_sum(sa); sb = wave_sum(sb);
        const float ra = 1.0f / sqrtf(sa * (1.f / 256.f) + EPS), rb = 1.0f / sqrtf(sb * (1.f / 256.f) + EPS);
        u32x2 wa, wb;
        wa.x = cvtpk(va.x * ra * gq.x, va.y * ra * gq.y); wa.y = cvtpk(va.z * ra * gq.z, va.w * ra * gq.w);
        wb.x = cvtpk(vb.x * rb * gk.x, vb.y * rb * gk.y); wb.y = cvtpk(vb.z * rb * gk.z, vb.w * rb * gk.w);
        *(u32x2*)(CNQ + (size_t)r * 256 + 4 * lane) = wa;
        *(u32x2*)(CNKV + (size_t)r * 256 + 4 * lane) = wb;
        const int pos = tok_pos(r), i = lane & 31;
        const float cs = cosT[pos * 32 + i], sn = sinT[pos * 32 + i];
        const float pr = __shfl_xor(kr, 32);
        const float o = lane < 32 ? kr * cs - pr * sn : pr * sn + kr * cs;
        KR[(size_t)r * 64 + lane] = (bf16_t)(cvtpk(o, 0.f) & 0xffffu);
    }
}

namespace att {
constexpr int LDS_V = 0, LDS_K = 16384, LDS_WS = 49152, LDS_TAB = 51200, LDS_STASH = 53248;
__device__ __forceinline__ int crow(int r, int hi) { return (r & 3) + 8 * (r >> 2) + 4 * hi; }
#define SBAR() __builtin_amdgcn_sched_barrier(0)
__device__ __forceinline__ int v_st(int k, int c) { const int kk = (k & ~0xC) | ((k & 4) << 1) | ((k & 8) >> 1); return ((kk >> 3) * 4 + (c >> 5)) * 512 + ((kk & 7) * 32 + (c & 31)) * 2; }
__device__ __forceinline__ int v_rd_base(int lane) { return ((lane & 3) << 3) | (((lane >> 2) & 3) << 6) | (((lane >> 4) & 1) << 5) | (((lane >> 5) & 1) << 8); }
constexpr int v_rd_off(int d0, int ks, int half) { return d0 * 512 + ks * 4096 + half * 2048; }
template <int OFF> __device__ __forceinline__ s16x4 tr_read(int vb) {
    s16x4 r; asm volatile("ds_read_b64_tr_b16 %0, %1 offset:%2" : "=&v"(r) : "v"(vb), "i"(OFF) : "memory"); return r;
}
template <int D0> __device__ __forceinline__ void pv_one(f32x16& od, int vb, bf16x8 pa0, bf16x8 pa1, bf16x8 pa2, bf16x8 pa3) {
    const s16x4 l0 = tr_read<v_rd_off(D0, 0, 0)>(vb), h0 = tr_read<v_rd_off(D0, 0, 1)>(vb), l1 = tr_read<v_rd_off(D0, 1, 0)>(vb), h1 = tr_read<v_rd_off(D0, 1, 1)>(vb);
    const s16x4 l2 = tr_read<v_rd_off(D0, 2, 0)>(vb), h2 = tr_read<v_rd_off(D0, 2, 1)>(vb), l3 = tr_read<v_rd_off(D0, 3, 0)>(vb), h3 = tr_read<v_rd_off(D0, 3, 1)>(vb);
    asm volatile("s_waitcnt lgkmcnt(0)" ::: "memory"); SBAR();
#define PK(L, H) (bf16x8){L[0], L[1], L[2], L[3], H[0], H[1], H[2], H[3]}
    od = __builtin_amdgcn_mfma_f32_32x32x16_bf16(pa0, PK(l0, h0), od, 0, 0, 0);
    od = __builtin_amdgcn_mfma_f32_32x32x16_bf16(pa1, PK(l1, h1), od, 0, 0, 0);
    od = __builtin_amdgcn_mfma_f32_32x32x16_bf16(pa2, PK(l2, h2), od, 0, 0, 0);
    od = __builtin_amdgcn_mfma_f32_32x32x16_bf16(pa3, PK(l3, h3), od, 0, 0, 0);
#undef PK
}

template <int DQK, bool MLAK, bool BIAS, bool PREFETCH>
__device__ __forceinline__ void attn_core(f32x16 (&o)[4], const bf16x8 (&qr)[DQK / 16],
                                          const bf16_t* __restrict__ Kg, int ldk, const bf16_t* __restrict__ K2g, const bf16_t* __restrict__ Vg, int ldv,
                                          int nkeys, float C, int qw0, LAS char* lds) {
    constexpr int PITCH = DQK * 2, CPR = DQK / 8, NKCH = DQK / 64;
    const int tid = otid(), wid = tid >> 6, lane = tid & 63, r32 = lane & 31, hi = lane >> 5;
    LAS char* V_lds = lds + LDS_V; LAS char* K_lds = lds + LDS_K;
    LAS float* wsf = (LAS float*)(lds + LDS_WS) + wid * 64; LAS float* li_l = wsf; LAS float* al_l = wsf + 32;
    const LAS float* tab = (const LAS float*)(lds + LDS_TAB);
    const int sr = tid >> 4, sc = (tid & 15) * 8, vst0 = v_st(sr, sc), vst1 = v_st(32 + sr, sc);
    const unsigned voff0 = (unsigned)(sr * ldv + sc), voff1 = (unsigned)((32 + sr) * ldv + sc);
    unsigned koff[NKCH]; int kdst[NKCH];
#pragma unroll
    for (int c = 0; c < NKCH; ++c) {
        int row, col;
        if (MLAK) { if (c < 2) { row = sr + 32 * c; col = sc; } else { row = tid >> 3; col = 128 + (tid & 7) * 8; } }
        else { const int id = tid + 512 * c; row = id / CPR; col = (id % CPR) * 8; }
        koff[c] = (MLAK && c == 2) ? (unsigned)(row * 64 + (col - 128)) : (unsigned)(row * ldk + col);
        kdst[c] = row * PITCH + ((col * 2) ^ ((row & 7) << 4)); }
    const int vb0 = (int)(unsigned)(uintptr_t)V_lds + v_rd_base(lane);
    const int kro = r32 * PITCH, kx = (r32 & 7) << 4;
    float m_reg = -1e30f, l_reg = 0.f;
#pragma unroll
    for (int d = 0; d < 4; ++d) o[d] = f32x16{};
    const int NT = nkeys / 64;
    bf16x8 vs0, vs1, ks[NKCH];
#define ATT_LOAD(t) do { const bf16_t* vt_ = Vg + (size_t)(t) * 64 * ldv; const bf16_t* kt_ = Kg + (size_t)(t) * 64 * ldk; const bf16_t* k2t_ = K2g + (size_t)(t) * 64 * 64; \
        vs0 = *(const bf16x8*)(vt_ + voff0); vs1 = *(const bf16x8*)(vt_ + voff1); \
        _Pragma("unroll") for (int c = 0; c < NKCH; ++c) ks[c] = *(const bf16x8*)(((MLAK && c == 2) ? k2t_ : kt_) + koff[c]); } while (0)
    if (PREFETCH) ATT_LOAD(0);
#pragma nounroll
    for (int j = 0; j < NT; ++j) {
        __syncthreads();
        if (!PREFETCH) ATT_LOAD(j);
        *(LAS bf16x8*)(V_lds + vst0) = vs0; *(LAS bf16x8*)(V_lds + vst1) = vs1;
#pragma unroll
        for (int c = 0; c < NKCH; ++c) *(LAS bf16x8*)(K_lds + kdst[c]) = ks[c];
        __syncthreads();
        if (PREFETCH && j + 1 < NT) ATT_LOAD(j + 1);
        f32x16 p0 = f32x16{}, p1 = f32x16{};
#pragma unroll
        for (int d0 = 0; d0 < DQK / 16; ++d0) { const int cb = ((d0 * 16 + hi * 8) * 2) ^ kx;
            const bf16x8 b0 = *(const LAS bf16x8*)(K_lds + kro + cb);
            const bf16x8 b1 = *(const LAS bf16x8*)(K_lds + kro + 32 * PITCH + cb);
            p0 = __builtin_amdgcn_mfma_f32_32x32x16_bf16(b0, qr[d0], p0, 0, 0, 0);
            p1 = __builtin_amdgcn_mfma_f32_32x32x16_bf16(b1, qr[d0], p1, 0, 0, 0); }
        if constexpr (BIAS) {
            const int kq = j * 64 - qw0;
            if (kq + 63 <= -128) { const float b = tab[0];
#pragma unroll
                for (int r = 0; r < 16; ++r) { p0[r] = fmaf(p0[r], C, b); p1[r] = fmaf(p1[r], C, b); } }
            else if (kq - 31 >= 128) { const float b = tab[256];
#pragma unroll
                for (int r = 0; r < 16; ++r) { p0[r] = fmaf(p0[r], C, b); p1[r] = fmaf(p1[r], C, b); } }
            else {
#pragma unroll
                for (int r = 0; r < 16; ++r) { const int i0 = kq + crow(r, hi) - r32 + 128;
                    const int a0 = min(max(i0, 0), 256), a1 = min(max(i0 + 32, 0), 256);
                    p0[r] = fmaf(p0[r], C, tab[a0]); p1[r] = fmaf(p1[r], C, tab[a1]); } }
        } else {
#pragma unroll
            for (int r = 0; r < 16; ++r) { p0[r] *= C; p1[r] *= C; }
        }
        float pmax = p0[0];
#pragma unroll
        for (int r = 1; r < 16; ++r) pmax = fmaxf(pmax, p0[r]);
#pragma unroll
        for (int r = 0; r < 16; ++r) pmax = fmaxf(pmax, p1[r]);
        { auto rr = __builtin_amdgcn_permlane32_swap(__float_as_uint(pmax), __float_as_uint(pmax), false, false);
          pmax = fmaxf(__uint_as_float(rr[0]), __uint_as_float(rr[1])); }
        const float mn = fmaxf(m_reg, pmax);
        const float alpha = __builtin_amdgcn_exp2f(m_reg - mn); m_reg = mn;
        float ps = 0.f;
#pragma unroll
        for (int r = 0; r < 16; ++r) { p0[r] = __builtin_amdgcn_exp2f(p0[r] - mn); p1[r] = __builtin_amdgcn_exp2f(p1[r] - mn); ps += p0[r] + p1[r]; }
        { auto rr = __builtin_amdgcn_permlane32_swap(__float_as_uint(ps), __float_as_uint(ps), false, false);
          ps = __uint_as_float(rr[0]) + __uint_as_float(rr[1]); }
        l_reg = l_reg * alpha + ps;
        if (__any(alpha < 1.f)) {
            if (hi == 0) al_l[r32] = alpha;
            asm volatile("s_waitcnt lgkmcnt(0)" ::: "memory");
#pragma unroll
            for (int r = 0; r < 16; ++r) { const float a = al_l[crow(r, hi)];
#pragma unroll
                for (int d = 0; d < 4; ++d) o[d][r] *= a; }
        }
        bf16x8 pa0, pa1, pa2, pa3;
#define PK4(P, BASE, OUT) do { unsigned a0 = cvtpk(P[BASE + 0], P[BASE + 1]), a1 = cvtpk(P[BASE + 2], P[BASE + 3]);   \
    unsigned b0 = cvtpk(P[BASE + 4], P[BASE + 5]), b1 = cvtpk(P[BASE + 6], P[BASE + 7]);                              \
    auto r0 = __builtin_amdgcn_permlane32_swap(a0, b0, false, false); auto r1 = __builtin_amdgcn_permlane32_swap(a1, b1, false, false); \
    u32x4 w = {r0[0], r1[0], r0[1], r1[1]}; OUT = *reinterpret_cast<bf16x8*>(&w); } while (0)
        PK4(p0, 0, pa0); PK4(p0, 8, pa1); PK4(p1, 0, pa2); PK4(p1, 8, pa3);
#undef PK4
        SBAR();
        pv_one<0>(o[0], vb0, pa0, pa1, pa2, pa3); pv_one<1>(o[1], vb0, pa0, pa1, pa2, pa3); pv_one<2>(o[2], vb0, pa0, pa1, pa2, pa3); pv_one<3>(o[3], vb0, pa0, pa1, pa2, pa3);
    }
    if (hi == 0) li_l[r32] = l_reg;
    asm volatile("s_waitcnt lgkmcnt(0)" ::: "memory");
#pragma unroll
    for (int r = 0; r < 16; ++r) { const float rl = 1.0f / li_l[crow(r, hi)];
#pragma unroll
        for (int d = 0; d < 4; ++d) o[d][r] *= rl; }
#undef ATT_LOAD
}

__device__ __forceinline__ void store_o(const f32x16 (&o)[4], bf16_t* Ob, int ldo, int r32, int hi) {
#pragma unroll
    for (int r = 0; r < 16; ++r) { bf16_t* p = Ob + (size_t)crow(r, hi) * ldo + r32;
#pragma unroll
        for (int d0 = 0; d0 < 4; ++d0) p[d0 * 32] = (bf16_t)(cvtpk(o[d0][r], 0.f) & 0xffffu); }
}
}

__device__ __forceinline__ void self_unit(int u, int& seqbase, int& S, int& h, int& qb) {
    if (u < 2048) { const int round = u >> 8, v = u & 255, x = v >> 5, j = v & 31; const int pair = x * 8 + round; S = SS; seqbase = MP + (pair >> 3) * SS; h = pair & 7; qb = j; }
    else { const int u2 = u - 2048, round = u2 >> 8, v = u2 & 255, x = v >> 5, j = v & 31; const int pair = x * 4 + round * 2 + (j >> 4); S = SP; seqbase = (pair >> 3) * SP; h = pair & 7; qb = j & 15; }
}

__device__ __forceinline__ void phase_mla_attn(const Params& P, LAS char* lds, int vcu, int G) {
    const int tid = otid(), wid = tid >> 6, lane = tid & 63, r32 = lane & 31, hi = lane >> 5;
    const bf16_t* Q = (const bf16_t*)(P.ws + O_Q); const bf16_t* KV = (const bf16_t*)(P.ws + O_KV); const bf16_t* KR = (const bf16_t*)(P.ws + O_KR);
    bf16_t* O = (bf16_t*)(P.ws + O_O);
    const float* cosT = (const float*)(P.ws + O_COS); const float* sinT = (const float*)(P.ws + O_SIN);
    const float C = 0.07216878364870323f * LOG2E;
#pragma nounroll
    for (int u = vcu; u < 2560; u += G) {
        int seqbase, S, h, qb; self_unit(u, seqbase, S, h, qb);
        const int pos = qb * 256 + wid * 32 + r32; const size_t row = (size_t)seqbase + pos;
        const bf16_t* qp = Q + row * 1536 + h * 192 + hi * 8;
        bf16x8 qr[12];
#pragma unroll
        for (int d0 = 0; d0 < 12; ++d0) qr[d0] = *(const bf16x8*)(qp + d0 * 16);
#pragma unroll
        for (int pr = 0; pr < 2; ++pr) { const int i0 = pr * 16 + hi * 8;
            const f32x4 c0 = *(const f32x4*)(cosT + pos * 32 + i0), c1 = *(const f32x4*)(cosT + pos * 32 + i0 + 4);
            const f32x4 s0 = *(const f32x4*)(sinT + pos * 32 + i0), s1 = *(const f32x4*)(sinT + pos * 32 + i0 + 4);
            const float cs[8] = {c0.x, c0.y, c0.z, c0.w, c1.x, c1.y, c1.z, c1.w}, sn[8] = {s0.x, s0.y, s0.z, s0.w, s1.x, s1.y, s1.z, s1.w};
            const bf16x8 x1 = qr[8 + pr], x2 = qr[10 + pr]; float o1[8], o2[8];
#pragma unroll
            for (int e = 0; e < 8; ++e) { const float a = bf1(x1[e]), b = bf1(x2[e]); o1[e] = a * cs[e] - b * sn[e]; o2[e] = a * sn[e] + b * cs[e]; }
            u32x4 w1 = {cvtpk(o1[0], o1[1]), cvtpk(o1[2], o1[3]), cvtpk(o1[4], o1[5]), cvtpk(o1[6], o1[7])};
            u32x4 w2 = {cvtpk(o2[0], o2[1]), cvtpk(o2[2], o2[3]), cvtpk(o2[4], o2[5]), cvtpk(o2[6], o2[7])};
            qr[8 + pr] = __builtin_bit_cast(bf16x8, w1); qr[10 + pr] = __builtin_bit_cast(bf16x8, w2); }
        f32x16 o[4];
        att::attn_core<192, true, false, true>(o, qr, KV + (size_t)seqbase * 2048 + h * 256, 2048, KR + (size_t)seqbase * 64, KV + (size_t)seqbase * 2048 + h * 256 + 128, 2048, S, C, 0, lds);
        att::store_o(o, O + ((size_t)seqbase + qb * 256 + wid * 32) * 1024 + h * 128, 1024, r32, hi);
    }
}

__device__ __forceinline__ void phase_xattn(const Params& P, int layer, LAS char* lds, int vcu, int G) {
    const int tid = otid(), wid = tid >> 6, lane = tid & 63, r32 = lane & 31, hi = lane >> 5;
    const bf16_t* XQ = (const bf16_t*)(P.ws + O_XQ); const bf16_t* MKV = (const bf16_t*)(P.ws + O_MKV) + (size_t)layer * NMR * 2048;
    bf16_t* O = (bf16_t*)(P.ws + O_O);
    const float C = 0.0625f * LOG2E;
#pragma nounroll
    for (int u = vcu; u < 2560; u += G) {
        const int vh = u & 1, h = (u >> 1) & 3, t = u >> 3; const int tok0 = t * 256;
        const int batch = tok0 < MP ? tok0 / SP : 4 + (tok0 - MP) / SS;
        const size_t row = (size_t)tok0 + wid * 32 + r32;
        const bf16_t* qp = XQ + row * 1024 + h * 256 + hi * 8;
        bf16x8 qr[16];
#pragma unroll
        for (int d0 = 0; d0 < 16; ++d0) qr[d0] = *(const bf16x8*)(qp + d0 * 16);
        const bf16_t* kb = MKV + (size_t)batch * 256 * 2048 + h * 256;
        f32x16 o[4];
        att::attn_core<256, false, false, false>(o, qr, kb, 2048, nullptr, kb + 1024 + vh * 128, 2048, 256, C, 0, lds);
        att::store_o(o, O + ((size_t)tok0 + wid * 32) * 1024 + h * 256 + vh * 128, 1024, r32, hi);
    }
}

__device__ __forceinline__ void phase_diff_attn(const Params& P, LAS char* lds, int vcu, int G) {
    const int tid = otid(), wid = tid >> 6, lane = tid & 63, r32 = lane & 31, hi = lane >> 5;
    const bf16_t* QKV = (const bf16_t*)(P.ws + O_QKV); bf16_t* O = (bf16_t*)(P.ws + O_O);
    const float* lam = P.in[13]; const float* subln = P.in[14]; const float* rbt = P.in[5];
    const float la = wave_sum(lam[lane] * lam[64 + lane]), lb = wave_sum(lam[128 + lane] * lam[192 + lane]);
    const float lam_full = expf(la) - expf(lb) + LAMBDA_INIT;
    const float C = 0.125f * LOG2E;
    LAS float* tab = (LAS float*)(lds + att::LDS_TAB);
    float sg[4];
#pragma unroll
    for (int d0 = 0; d0 < 4; ++d0) sg[d0] = subln[d0 * 32 + r32] * (1.0f - LAMBDA_INIT);
#pragma nounroll
    for (int u = vcu; u < 2560; u += G) {
        int seqbase, S, h, qb; self_unit(u, seqbase, S, h, qb);
        __syncthreads();
        for (int idx = tid; idx < 257; idx += 512) { const int rel = idx - 128, n = rel < 0 ? -rel : rel;
            int b = n < 8 ? n : (n < 12 ? 8 : n < 16 ? 9 : n < 23 ? 10 : n < 32 ? 11 : n < 46 ? 12 : n < 64 ? 13 : n < 91 ? 14 : 15);
            if (rel > 0) b += 16;
            tab[idx] = rbt[b * 8 + h] * LOG2E; }
        const int qw0 = qb * 256 + wid * 32; const size_t row = (size_t)seqbase + qw0 + r32;
        const bf16_t* base = QKV + (size_t)seqbase * 3072;
        f32x16 oa[4], ob[4];
        LAS unsigned* stash = (LAS unsigned*)(lds + att::LDS_STASH) + tid;
        { bf16x8 qr[4]; const bf16_t* qp = QKV + row * 3072 + h * 128 + hi * 8;
#pragma unroll
          for (int d0 = 0; d0 < 4; ++d0) qr[d0] = *(const bf16x8*)(qp + d0 * 16);
          att::attn_core<64, false, true, true>(oa, qr, base + 1024 + h * 128, 3072, nullptr, base + 2048 + h * 128, 3072, S, C, qw0, lds); }
#pragma unroll
        for (int d0 = 0; d0 < 4; ++d0)
#pragma unroll
            for (int r = 0; r < 16; r += 2) stash[(d0 * 8 + (r >> 1)) * 512] = cvtpk(oa[d0][r], oa[d0][r + 1]);
        { bf16x8 qr[4]; const bf16_t* qp = QKV + row * 3072 + h * 128 + 64 + hi * 8;
#pragma unroll
          for (int d0 = 0; d0 < 4; ++d0) qr[d0] = *(const bf16x8*)(qp + d0 * 16);
          att::attn_core<64, false, true, true>(ob, qr, base + 1024 + h * 128 + 64, 3072, nullptr, base + 2048 + h * 128, 3072, S, C, qw0, lds); }
#pragma unroll
        for (int r = 0; r < 16; ++r) { float s = 0.f;
#pragma unroll
            for (int d0 = 0; d0 < 4; ++d0) { const unsigned w = stash[(d0 * 8 + (r >> 1)) * 512]; const float a = (r & 1) ? bfhi(w) : bflo(w); const float v = a - lam_full * ob[d0][r]; oa[d0][r] = v; s += v * v; }
            s += __shfl_xor(s, 1); s += __shfl_xor(s, 2); s += __shfl_xor(s, 4); s += __shfl_xor(s, 8); s += __shfl_xor(s, 16);
            const float rs = 1.0f / sqrtf(s * (1.f / 128.f) + EPS);
#pragma unroll
            for (int d0 = 0; d0 < 4; ++d0) oa[d0][r] *= rs * sg[d0]; }
        att::store_o(oa, O + ((size_t)seqbase + qw0) * 1024 + h * 128, 1024, r32, hi);
    }
}

struct GemmDesc { const bf16_t* A; const bf16_t* Bt; bf16_t* C; int M, N, K, act; };
__device__ __forceinline__ int gemm_desc(int ph, int sub, unsigned char* ws, GemmDesc& d) {
#define BP(off) ((bf16_t*)(ws + (off)))
    const int L = ph >= 14 ? 1 : 0;
    switch (ph) {
    case 1:
        if (sub < 2) { d = GemmDesc{BP(O_MEMN) + (size_t)sub * NMR * 1024, BP(O_W_XKV + (size_t)sub * 4 * MiB), BP(O_MKV) + (size_t)sub * NMR * 2048, NMR, 2048, 1024, 0}; }
        else { d = GemmDesc{BP(O_XH), BP(O_W_MLA_IN), BP(O_C), MT, 768, 1024, 0}; }
        return 3;
    case 3:
        if (sub == 0) d = GemmDesc{BP(O_CNQ), BP(O_W_MLA_UQ), BP(O_Q), MT, 1536, 256, 0};
        else d = GemmDesc{BP(O_CNKV), BP(O_W_MLA_UKV), BP(O_KV), MT, 2048, 256, 0};
        return 2;
    case 5: d = GemmDesc{BP(O_O), BP(O_W_MLA_O), BP(O_XH), MT, 1024, 1024, 0}; return 1;
    case 7: case 18: d = GemmDesc{BP(O_XH), BP(O_W_XQ + (size_t)L * 2 * MiB), BP(O_XQ), MT, 1024, 1024, 0}; return 1;
    case 9: case 20: d = GemmDesc{BP(O_O), BP(O_W_XO + (size_t)L * 2 * MiB), BP(O_XH), MT, 1024, 1024, 0}; return 1;
    case 11: case 22: d = GemmDesc{BP(O_XH), BP(O_W_1 + (size_t)L * 8 * MiB), BP(O_ACT), MT, 4096, 1024, 1}; return 1;
    case 12: case 23: d = GemmDesc{BP(O_ACT), BP(O_W_2 + (size_t)L * 8 * MiB), BP(O_XH), MT, 1024, 4096, 0}; return 1;
    case 14: d = GemmDesc{BP(O_XH), BP(O_W_DIFF_IN), BP(O_QKV), MT, 3072, 1024, 0}; return 1;
    case 16: d = GemmDesc{BP(O_O), BP(O_W_DIFF_O), BP(O_XH), MT, 1024, 1024, 0}; return 1;
    default: return 0;
    }
#undef BP
}

__global__ void __launch_bounds__(512, 2) mk_fwd(Params P) {
    extern __shared__ __attribute__((aligned(16))) unsigned char lds_raw[];
    cg::grid_group grid = cg::this_grid();
    LAS unsigned char* lds = (LAS unsigned char*)lds_raw;
    const int G = gridDim.x, bx = blockIdx.x;
    const int vcu = (G % 8 == 0) ? (bx % 8) * (G / 8) + bx / 8 : bx;
    const int NGW = G * 8;
    const float* gains = P.in[4];
#pragma nounroll
    for (int ph = 0; ph < NPH_LIMIT; ++ph) {
        const int tid = otid(), lane = tid & 63, wave = __builtin_amdgcn_readfirstlane(tid >> 6);
        const int gw = vcu * 8 + wave;
        if (ph == 0) phase_prologue(P, lds, gw, NGW, wave, lane);
        else if (ph == 2) phase_cnorm(P, gw, NGW, lane);
#ifndef SKIP_MLA
        else if (ph == 4) phase_mla_attn(P, (LAS char*)lds, vcu, G);
#endif
#ifndef SKIP_DIFF
        else if (ph == 15) phase_diff_attn(P, (LAS char*)lds, vcu, G);
#endif
#ifndef SKIP_XATTN
        else if (ph == 8 || ph == 19) phase_xattn(P, ph == 8 ? 0 : 1, (LAS char*)lds, vcu, G);
#endif
        else if (ph == 6 || ph == 10 || ph == 13 || ph == 17 || ph == 21 || ph == 24) {
            const int L = ph >= 14 ? 1 : 0; const int k = (ph == 6 || ph == 17) ? 1 : (ph == 10 || ph == 21) ? 3 : 5;
            const float* ga = gains + (L * 6 + k) * DM;
            const float* gb = (k < 5) ? gains + (L * 6 + k + 1) * DM : (L == 0 ? gains + 6 * DM : nullptr);
            phase_resnorm(P, ga, gb, gw, NGW, lane);
        } else {
            GemmDesc d; const int n = gemm_desc(ph, 0, P.ws, d);
#pragma nounroll
            for (int sub = 0; sub < n; ++sub) {
                gemm_desc(ph, sub, P.ws, d);
                pg8::Gemm g{d.A, d.Bt, d.M, d.N, d.K}; pg8::StaticOrder S; S.init(d.M, d.N, G, bx);
                pg8::EpiRt E{d.C, d.N, d.act};
#ifndef SKIP_GEMM
                pg8::gemm_phase<pg8::EpiRt, pg8::StaticOrder, true, true>(lds, g, S, E);
#endif
                __syncthreads();
            }
        }
        grid.sync();
    }
}

extern "C" void kernel_launch(void* const* d_in, const int* in_sizes, int n_in, void* d_out, int out_size, void* d_ws, size_t ws_size, hipStream_t stream) {
    static int grid = 0;
    if (grid == 0) {
        if (n_in != 22 || out_size != MT * DM || ws_size < WS_END) {
            fprintf(stderr, "kernel_launch: unexpected shapes: n_in %d out %d ws %zu (need %zu)\n", n_in, out_size, ws_size, (size_t)WS_END); grid = -1; return; }
        int dev = 0, cus = 0, per_cu = 0;
        if (hipGetDevice(&dev) != hipSuccess || hipDeviceGetAttribute(&cus, hipDeviceAttributeMultiprocessorCount, dev) != hipSuccess) { fprintf(stderr, "kernel_launch: device query failed\n"); grid = -1; return; }
        if (hipFuncSetAttribute((const void*)mk_fwd, hipFuncAttributeMaxDynamicSharedMemorySize, LDS_BYTES) != hipSuccess) { fprintf(stderr, "kernel_launch: hipFuncSetAttribute failed\n"); grid = -1; return; }
        if (hipOccupancyMaxActiveBlocksPerMultiprocessor(&per_cu, (const void*)mk_fwd, 512, LDS_BYTES) != hipSuccess || per_cu < 1) { fprintf(stderr, "kernel_launch: occupancy query gave %d\n", per_cu); per_cu = 1; (void)hipGetLastError(); }
        grid = cus * per_cu;
    }
    if (grid < 0) return;
    Params p{};
    for (int i = 0; i < 22; ++i) p.in[i] = (const float*)d_in[i];
    p.out = (float*)d_out; p.ws = (unsigned char*)d_ws;
    void* args[] = {&p};
    hipError_t e = hipLaunchCooperativeKernel((const void*)mk_fwd, dim3(grid), dim3(512), args, LDS_BYTES, stream);
    if (e != hipSuccess) fprintf(stderr, "kernel_launch: cooperative launch failed: %s (grid %d)\n", hipGetErrorString(e), grid);
}
```

```cpp
#include <hip/hip_runtime.h>
#include <hip/hip_cooperative_groups.h>
#include <cstdio>
#include <cstdint>
namespace cg = cooperative_groups;
namespace pg8 {
#define PG8_LAS __attribute__((address_space(3)))
typedef unsigned short bf16_t;
typedef short bf16x8 __attribute__((ext_vector_type(8)));
typedef float f32x4 __attribute__((ext_vector_type(4)));
typedef unsigned u32x4 __attribute__((ext_vector_type(4)));
constexpr int BM = 256, BK = 64, HALF = 128, HTB = HALF * BK * 2  , STAGE_BYTES = 8 * HTB, NXCD = 8, WGM = 8;

__host__ __device__ __forceinline__ int lds_byte(int r, int c) { const int st = (r >> 4) * 2 + (c >> 5), rr = r & 15, cc = c & 31, ob = rr * 64 + cc * 2; return st * 1024 + (ob ^ (((ob >> 9) & 1) << 5)); }
__host__ __device__ __forceinline__ void stage_rc(int b, int& R, int& C) { const int st = b / 1024, sb = b % 1024, swz = sb ^ (((sb >> 9) & 1) << 5); R = (st >> 1) * 16 + swz / 64; C = (st & 1) * 32 + (swz % 64) / 2; }
__host__ __device__ __forceinline__ int perm32(int rho) { const int n = rho >> 4, i = rho & 15; return 8 * (i >> 2) + 4 * n + (i & 3); }

struct Unit { int pm, pn; };
struct Gemm { const bf16_t* A; const bf16_t* Bt; int M, N, K; };

struct StaticOrder {
    int nM, nN, nwg, G, c;
    __host__ __device__ void init(int M, int N, int G_, int c_) { nM = M / BM; nN = N / BM; nwg = nM * nN; G = G_; c = c_; }
    __host__ __device__ bool next(int i, Unit& u) const {
        const long L = (long)i * G + c; if (L >= nwg) return false;
        int wgid = (int)L; { const int q = nwg / NXCD, r = nwg % NXCD, xcd = wgid % NXCD, off = wgid / NXCD; wgid = (xcd < r ? xcd * (q + 1) : r * (q + 1) + (xcd - r) * q) + off; }
        const int nig = WGM * nN, gid = wgid / nig, fm = gid * WGM, gsz = (nM - fm) < WGM ? (nM - fm) : WGM;
        u.pm = fm + ((wgid % nig) % gsz); u.pn = (wgid % nig) / gsz; return true;
    }
    __device__ __forceinline__ void a_ready(const Unit&) const {}
    __device__ __forceinline__ void done(const Unit&) const {}
};

__device__ __forceinline__ unsigned cvt_pk_bf16(float lo, float hi) { unsigned r; asm volatile("v_cvt_pk_bf16_f32 %0, %1, %2" : "=v"(r) : "v"(lo), "v"(hi)); return r; }
typedef float f32x2 __attribute__((ext_vector_type(2)));
struct EpiRt {
    static constexpr bool PERM = true, AFTER_DRAIN = false;
    bf16_t* O; int ldc; int act;
    __device__ __forceinline__ void operator()(const f32x4 (&acc)[2][2][4][2], const Unit& u, int wr, int wc, int fr, int fq) const {
        const int row0 = u.pm * BM + wr * 64 + fr; const int col0 = u.pn * BM + wc * 32 + 8 * fq;
#pragma unroll
        for (int ai = 0; ai < 2; ++ai)
#pragma unroll
            for (int m = 0; m < 4; ++m) { bf16_t* rowp = O + (size_t)(row0 + ai * HALF + m * 16) * ldc + col0;
#pragma unroll
                for (int bj = 0; bj < 2; ++bj) { f32x4 v0 = acc[ai][bj][m][0], v1 = acc[ai][bj][m][1];
                    if (act) {
#pragma unroll
                        for (int e = 0; e < 4; ++e) { float a = fmaxf(v0[e], 0.f), b = fmaxf(v1[e], 0.f); v0[e] = a * a; v1[e] = b * b; } }
                    u32x4 w; w.x = cvt_pk_bf16(v0[0], v0[1]); w.y = cvt_pk_bf16(v0[2], v0[3]); w.z = cvt_pk_bf16(v1[0], v1[1]); w.w = cvt_pk_bf16(v1[2], v1[3]);
                    *(u32x4*)(rowp + bj * HALF) = w; } }
    }
};
template <class Epi, class Sched, bool ALIGN_EPI = false, bool SP2 = false>
__device__ __forceinline__ void gemm_phase(PG8_LAS unsigned char* lds, const Gemm g, const Sched& S, const Epi& E) {
    int tid_ = threadIdx.x; asm volatile("" : "+v"(tid_)); const int tid = tid_, wid = __builtin_amdgcn_readfirstlane(tid >> 6), lane = tid & 63, wr = wid >> 2, wc = wid & 3, fr = lane & 15, fq = lane >> 4;
    const int K = g.K, nt = K / BK;
    unsigned voffA[2], voffB[2];
#pragma unroll
    for (int i = 0; i < 2; ++i) { int R, C; stage_rc(tid * 16 + i * 8192, R, C); const int Rb = Epi::PERM ? ((R & ~31) + perm32(R & 31)) : R;
        voffA[i] = (unsigned)(R * K + C) * 2u; voffB[i] = (unsigned)(Rb * K + C) * 2u; }
    const size_t kstep = (size_t)(BK * 2);
    const size_t hstep = (size_t)HALF * K * 2;
    const size_t tstep = 2 * hstep;
    const unsigned ldsw = (unsigned)wid * 1024u;
    const int aoff = lds_byte(wr * 64 + fr, fq * 8), boff = lds_byte(wc * 32 + fr, fq * 8);
#define PG8_SA(b, h) (((b) * 2 + (h)) * HTB)
#define PG8_SB(b, h) ((4 + (b) * 2 + (h)) * HTB)
#define PG8_STAGE(bufoff, gbase, voff) do { _Pragma("unroll") for (int _i = 0; _i < 2; ++_i) \
        __builtin_amdgcn_global_load_lds((const unsigned*)((const char*)(gbase) + (voff)[_i]), (PG8_LAS unsigned*)(lds + (bufoff) + ldsw + _i * 8192), 16, 0, 0); } while (0)
#define PG8_LDA(dst, b, h) do { _Pragma("unroll") for (int m = 0; m < 4; ++m) _Pragma("unroll") for (int k = 0; k < 2; ++k) dst[m][k] = *(const PG8_LAS bf16x8*)(lds + PG8_SA(b, h) + aoff + m * 2048 + k * 1024); } while (0)
#define PG8_LDB(dst, b, h) do { _Pragma("unroll") for (int n = 0; n < 2; ++n) _Pragma("unroll") for (int k = 0; k < 2; ++k) dst[n][k] = *(const PG8_LAS bf16x8*)(lds + PG8_SB(b, h) + boff + n * 2048 + k * 1024); } while (0)
#define PG8_MMA(ai, bj, At, Bt) do { __builtin_amdgcn_s_setprio(1); _Pragma("unroll") for (int m = 0; m < 4; ++m) _Pragma("unroll") for (int n = 0; n < 2; ++n) _Pragma("unroll") for (int k = 0; k < 2; ++k) \
        acc[ai][bj][m][n] = __builtin_amdgcn_mfma_f32_16x16x32_bf16(Bt[n][k], At[m][k], acc[ai][bj][m][n], 0, 0, 0); __builtin_amdgcn_s_setprio(0); } while (0)
#define PG8_WAIT_V(n) asm volatile("s_waitcnt vmcnt(" #n ")" ::: "memory")
#define PG8_WAIT_L(n) asm volatile("s_waitcnt lgkmcnt(" #n ")" ::: "memory")
#define PG8_BAR __builtin_amdgcn_s_barrier()
#define PG8_SCHED __builtin_amdgcn_sched_barrier(0)
    Unit cur, nxt; int ui = 0;
    if (!S.next(0, cur)) return;
    f32x4 acc[2][2][4][2];
#pragma unroll
    for (int a = 0; a < 2; ++a)
#pragma unroll
        for (int b = 0; b < 2; ++b)
#pragma unroll
            for (int m = 0; m < 4; ++m)
#pragma unroll
                for (int n = 0; n < 2; ++n) acc[a][b][m][n] = (f32x4){0.f, 0.f, 0.f, 0.f};
    bf16x8 At[4][2], B0[2][2], B1[2][2];
    const char* cA = (const char*)g.A + (size_t)cur.pm * tstep; const char* cB = (const char*)g.Bt + (size_t)cur.pn * tstep;
    S.a_ready(cur);
    if constexpr (SP2) {
        PG8_STAGE(PG8_SB(0, 0), cB, voffB); PG8_STAGE(PG8_SB(0, 1), cB + hstep, voffB); PG8_STAGE(PG8_SA(0, 0), cA, voffA); PG8_STAGE(PG8_SA(0, 1), cA + hstep, voffA);
        if (wr == 1) PG8_BAR;
        PG8_WAIT_V(2); PG8_BAR;
        PG8_STAGE(PG8_SB(1, 0), cB + kstep, voffB); PG8_STAGE(PG8_SA(1, 0), cA + kstep, voffA); PG8_STAGE(PG8_SB(1, 1), cB + hstep + kstep, voffB);
        PG8_WAIT_V(6); PG8_BAR;
    } else {
        PG8_STAGE(PG8_SB(0, 0), cB, voffB); PG8_STAGE(PG8_SA(0, 0), cA, voffA); PG8_STAGE(PG8_SB(0, 1), cB + hstep, voffB); PG8_STAGE(PG8_SA(0, 1), cA + hstep, voffA);
        if (wr == 1) PG8_BAR;
        PG8_WAIT_V(4); PG8_BAR;
        PG8_STAGE(PG8_SB(1, 0), cB + kstep, voffB); PG8_STAGE(PG8_SA(1, 0), cA + kstep, voffA); PG8_STAGE(PG8_SB(1, 1), cB + hstep + kstep, voffB);
        PG8_WAIT_V(6); PG8_BAR;
    }
    for (;;) {
        const bool has_next = S.next(ui + 1, nxt);
        const char* nA = has_next ? (const char*)g.A + (size_t)nxt.pm * tstep : cA; const char* nB = has_next ? (const char*)g.Bt + (size_t)nxt.pn * tstep : cB;
        for (int t = 0; t < nt; t += 2) {
            const bool last = (t == nt - 2);
            const char* a1 = cA + (size_t)(t + 1) * kstep;
            const char* a2 = last ? nA : cA + (size_t)(t + 2) * kstep; const char* b2 = last ? nB : cB + (size_t)(t + 2) * kstep;
            const char* a3 = a2 + kstep; const char* b3 = b2 + kstep;
            if (last && has_next) S.a_ready(nxt);
            if constexpr (SP2) {
            PG8_LDB(B0, 0, 0); PG8_LDB(B1, 0, 1); PG8_SCHED; PG8_LDA(At, 0, 0); PG8_STAGE(PG8_SA(1, 1), a1 + hstep, voffA);
            PG8_WAIT_V(8); PG8_WAIT_L(0); PG8_BAR; PG8_MMA(0, 0, At, B0); PG8_MMA(0, 1, At, B1); PG8_BAR; PG8_SCHED;
            PG8_LDA(At, 0, 1); PG8_STAGE(PG8_SB(0, 0), b2, voffB); PG8_STAGE(PG8_SB(0, 1), b2 + hstep, voffB); PG8_STAGE(PG8_SA(0, 0), a2, voffA);
            PG8_WAIT_V(8); PG8_WAIT_L(0); PG8_BAR; PG8_MMA(1, 0, At, B0); PG8_MMA(1, 1, At, B1); PG8_BAR; PG8_SCHED;
            PG8_LDB(B0, 1, 0); PG8_LDB(B1, 1, 1); PG8_SCHED; PG8_LDA(At, 1, 0); PG8_STAGE(PG8_SA(0, 1), a2 + hstep, voffA);
            PG8_WAIT_V(8); PG8_WAIT_L(0); PG8_BAR; PG8_MMA(0, 0, At, B0); PG8_MMA(0, 1, At, B1); PG8_BAR; PG8_SCHED;
            PG8_LDA(At, 1, 1); PG8_STAGE(PG8_SB(1, 0), b3, voffB); PG8_STAGE(PG8_SB(1, 1), b3 + hstep, voffB); PG8_STAGE(PG8_SA(1, 0), a3, voffA);
            PG8_WAIT_V(8); PG8_WAIT_L(0); PG8_BAR; PG8_MMA(1, 0, At, B0); PG8_MMA(1, 1, At, B1); PG8_BAR; PG8_SCHED;
            } else {
            PG8_LDB(B0, 0, 0); PG8_SCHED; PG8_LDA(At, 0, 0); PG8_STAGE(PG8_SA(1, 1), a1 + hstep, voffA);
            PG8_WAIT_L(8); PG8_BAR; PG8_WAIT_L(0); PG8_MMA(0, 0, At, B0); PG8_BAR; PG8_SCHED;
            PG8_LDB(B1, 0, 1); PG8_STAGE(PG8_SB(0, 0), b2, voffB);
            PG8_BAR; PG8_WAIT_L(0); PG8_MMA(0, 1, At, B1); PG8_BAR;
            PG8_LDA(At, 0, 1); PG8_STAGE(PG8_SA(0, 0), a2, voffA);
            PG8_BAR; PG8_WAIT_L(0); PG8_MMA(1, 0, At, B0); PG8_BAR; PG8_SCHED;
            PG8_STAGE(PG8_SB(0, 1), b2 + hstep, voffB);
            PG8_WAIT_V(6); PG8_BAR; PG8_MMA(1, 1, At, B1); PG8_BAR;
            PG8_LDB(B0, 1, 0); PG8_SCHED; PG8_LDA(At, 1, 0); PG8_STAGE(PG8_SA(0, 1), a2 + hstep, voffA);
            PG8_WAIT_L(8); PG8_BAR; PG8_WAIT_L(0); PG8_MMA(0, 0, At, B0); PG8_BAR; PG8_SCHED;
            PG8_LDB(B1, 1, 1); PG8_STAGE(PG8_SB(1, 0), b3, voffB);
            PG8_BAR; PG8_WAIT_L(0); PG8_MMA(0, 1, At, B1); PG8_BAR;
            PG8_LDA(At, 1, 1); PG8_STAGE(PG8_SA(1, 0), a3, voffA);
            PG8_BAR; PG8_WAIT_L(0); PG8_MMA(1, 0, At, B0); PG8_BAR; PG8_SCHED;
            PG8_STAGE(PG8_SB(1, 1), b3 + hstep, voffB);
            PG8_WAIT_V(6); PG8_BAR; PG8_MMA(1, 1, At, B1); PG8_BAR;
            }
        }
        if constexpr (ALIGN_EPI) { if (wr == 0) PG8_BAR; }
        if constexpr (!Epi::AFTER_DRAIN) { E(acc, cur, wr, wc, fr, fq); S.done(cur); }
        if (!has_next) break;
#pragma unroll
        for (int a = 0; a < 2; ++a)
#pragma unroll
            for (int b = 0; b < 2; ++b)
#pragma unroll
                for (int m = 0; m < 4; ++m)
#pragma unroll
                    for (int n = 0; n < 2; ++n) acc[a][b][m][n] = (f32x4){0.f, 0.f, 0.f, 0.f};
        cur = nxt; cA = nA; cB = nB; ++ui;
        if constexpr (ALIGN_EPI) { if (wr == 1) PG8_BAR; }
    }
    PG8_WAIT_V(0);
    if constexpr (!ALIGN_EPI) { if (wr == 0) PG8_BAR; }
    PG8_BAR;
    if constexpr (Epi::AFTER_DRAIN) { E.fused(acc, cur, wr, wc, fr, fq, lds, wid, lane); S.done(cur); }
#undef PG8_SA
#undef PG8_SB
#undef PG8_STAGE
#undef PG8_LDA
#undef PG8_LDB
#undef PG8_MMA
#undef PG8_WAIT_V
#undef PG8_WAIT_L
#undef PG8_BAR
#undef PG8_SCHED
}
}

#define LAS __attribute__((address_space(3)))
typedef unsigned short bf16_t;
typedef short bf16x8 __attribute__((ext_vector_type(8)));
typedef short s16x4 __attribute__((ext_vector_type(4)));
typedef float f32x4 __attribute__((ext_vector_type(4)));
typedef float f32x16 __attribute__((ext_vector_type(16)));
typedef unsigned u32x4 __attribute__((ext_vector_type(4)));
typedef unsigned u32x2 __attribute__((ext_vector_type(2)));

#ifndef REPEAT_MASK
#define REPEAT_MASK 0u
#endif
#ifndef NPH_LIMIT
#define NPH_LIMIT 25
#endif

constexpr int DM = 1024, MP = 4 * 4096, MS = 8 * 8192, MT = MP + MS;
constexpr int SP = 4096, SS = 8192;
constexpr int NMR = 12 * 256;
constexpr float EPS = 1e-6f, LOG2E = 1.4426950408889634f;
constexpr float LAMBDA_INIT = 0.35550906759f;

constexpr size_t MiB = 1u << 20;
constexpr size_t O_COS = 1 * MiB, O_SIN = 2 * MiB;
constexpr size_t O_W_MLA_IN = 3 * MiB;
constexpr size_t O_W_MLA_UQ = O_W_MLA_IN + 2 * MiB;
constexpr size_t O_W_MLA_UKV = O_W_MLA_UQ + 1 * MiB;
constexpr size_t O_W_MLA_O = O_W_MLA_UKV + 1 * MiB;
constexpr size_t O_W_DIFF_IN = O_W_MLA_O + 2 * MiB;
constexpr size_t O_W_DIFF_O = O_W_DIFF_IN + 6 * MiB;
constexpr size_t O_W_XQ = O_W_DIFF_O + 2 * MiB;
constexpr size_t O_W_XKV = O_W_XQ + 4 * MiB;
constexpr size_t O_W_XO = O_W_XKV + 8 * MiB;
constexpr size_t O_W_1 = O_W_XO + 4 * MiB;
constexpr size_t O_W_2 = O_W_1 + 16 * MiB;
constexpr size_t O_MEMN = O_W_2 + 16 * MiB;
constexpr size_t O_MKV = O_MEMN + 12 * MiB;
constexpr size_t A0 = 104 * MiB;
static_assert(O_MKV + 24 * MiB <= A0, "fixed region");
constexpr size_t O_XH = A0;
constexpr size_t O_CNKV = A0, O_KR = A0 + 40 * MiB;
constexpr size_t O_O = A0 + 160 * MiB;
constexpr size_t O_C = O_O, O_CNQ = O_O + 120 * MiB;
constexpr size_t O_ACT = A0 + 160 * MiB;
constexpr size_t O_BR = A0 + 320 * MiB;
constexpr size_t O_Q = O_BR, O_KV = O_BR + 240 * MiB, O_XQ = O_BR, O_QKV = O_BR;
constexpr size_t WS_END = A0 + 880 * MiB;
static_assert(WS_END <= 1024 * MiB, "workspace");

constexpr int LDS_BYTES = 131072 + 8192;

struct Params { const float* in[22]; float* out; unsigned char* ws; };

__device__ __forceinline__ unsigned cvtpk(float lo, float hi) { unsigned r; asm volatile("v_cvt_pk_bf16_f32 %0, %1, %2" : "=v"(r) : "v"(lo), "v"(hi)); return r; }
__device__ __forceinline__ int otid() { int t = threadIdx.x; asm volatile("" : "+v"(t)); return t; }
__device__ __forceinline__ float bflo(unsigned w) { return __uint_as_float(w << 16); }
__device__ __forceinline__ float bfhi(unsigned w) { return __uint_as_float(w & 0xffff0000u); }
__device__ __forceinline__ float bf1(short s) { return __uint_as_float(((unsigned)(unsigned short)s) << 16); }
__device__ __forceinline__ float wave_sum(float v) {
#pragma unroll
    for (int o = 1; o < 64; o <<= 1) v += __shfl_xor(v, o);
    return v;
}
__device__ __forceinline__ int tok_pos(int row) { return row < MP ? (row & (SP - 1)) : ((row - MP) & (SS - 1)); }

__device__ __forceinline__ void transpose_item(const float* __restrict__ W, int K, int N, bf16_t* __restrict__ WT, LAS float* scr, int item, int lane) {
    const int nblk = N / 32, kb = item / nblk, nb = item % nblk, k0 = 64 * kb, n0 = 32 * nb;
#pragma unroll 8
    for (int i = 0; i < 32; ++i) { const int kk = 2 * i + (lane >> 5); scr[kk * 33 + (lane & 31)] = W[(size_t)(k0 + kk) * N + n0 + (lane & 31)]; }
    asm volatile("s_waitcnt lgkmcnt(0)" ::: "memory");
    const int c = lane & 7;
#pragma unroll
    for (int j = 0; j < 4; ++j) { const int n = (lane >> 3) + 8 * j; const LAS float* s = scr + (8 * c) * 33 + n;
        u32x4 o; o.x = cvtpk(s[0 * 33], s[1 * 33]); o.y = cvtpk(s[2 * 33], s[3 * 33]); o.z = cvtpk(s[4 * 33], s[5 * 33]); o.w = cvtpk(s[6 * 33], s[7 * 33]);
        *(u32x4*)(WT + (size_t)(n0 + n) * K + k0 + 8 * c) = o; }
    asm volatile("s_waitcnt lgkmcnt(0)" ::: "memory");
}

__device__ __forceinline__ void norm_store_row(const f32x4 (&v)[4], const float* __restrict__ g, bf16_t* __restrict__ orow, int lane) {
    float s = 0.f;
#pragma unroll
    for (int j = 0; j < 4; ++j) s += (v[j].x * v[j].x + v[j].y * v[j].y) + (v[j].z * v[j].z + v[j].w * v[j].w);
    s = wave_sum(s);
    const float rs = 1.0f / sqrtf(s * (1.f / 1024.f) + EPS);
#pragma unroll
    for (int j = 0; j < 4; ++j) { const f32x4 gg = *(const f32x4*)(g + 4 * lane + 256 * j);
        u32x2 w; w.x = cvtpk(v[j].x * rs * gg.x, v[j].y * rs * gg.y); w.y = cvtpk(v[j].z * rs * gg.z, v[j].w * rs * gg.w);
        *(u32x2*)(orow + 4 * lane + 256 * j) = w; }
}

__device__ __forceinline__ void phase_prologue(const Params& P, LAS unsigned char* lds, int gw, int NGW, int wave, int lane) {
    unsigned char* ws = P.ws;
    LAS float* scr = (LAS float*)(lds + wave * 16384);
    {
        constexpr int I0 = (1024 / 64) * (576 / 32), I1 = (256 / 64) * (1536 / 32), I2 = (256 / 64) * (2048 / 32), I3 = (1024 / 64) * (1024 / 32),
                      I4 = (1024 / 64) * (3072 / 32), I5 = I3, I6 = I3, I7 = (1024 / 64) * (2048 / 32), I8 = I3, I9 = (1024 / 64) * (4096 / 32), I10 = (4096 / 64) * (1024 / 32);
        constexpr int NIT = I0 + I1 + I2 + I3 + I4 + I5 + 2 * I6 + 2 * I7 + 2 * I8 + 2 * I9 + 2 * I10;
        for (int it = gw; it < NIT; it += NGW) {
            int r = it;
#define TJ(CNT, SRC, KK, NN, DST) if (r < (CNT)) { transpose_item((SRC), (KK), (NN), (bf16_t*)(ws + (DST)), scr, r, lane); continue; } r -= (CNT);
            TJ(I0, P.in[6], 1024, 576, O_W_MLA_IN)
            TJ(I1, P.in[9], 256, 1536, O_W_MLA_UQ)
            TJ(I2, P.in[10], 256, 2048, O_W_MLA_UKV)
            TJ(I3, P.in[11], 1024, 1024, O_W_MLA_O)
            TJ(I4, P.in[12], 1024, 3072, O_W_DIFF_IN)
            TJ(I5, P.in[15], 1024, 1024, O_W_DIFF_O)
            TJ(I6, P.in[17], 1024, 1024, O_W_XQ)
            TJ(I6, P.in[17] + 1024 * 1024, 1024, 1024, O_W_XQ + 2 * MiB)
            TJ(I7, P.in[18], 1024, 2048, O_W_XKV)
            TJ(I7, P.in[18] + 1024 * 2048, 1024, 2048, O_W_XKV + 4 * MiB)
            TJ(I8, P.in[19], 1024, 1024, O_W_XO)
            TJ(I8, P.in[19] + 1024 * 1024, 1024, 1024, O_W_XO + 2 * MiB)
            TJ(I9, P.in[20], 1024, 4096, O_W_1)
            TJ(I9, P.in[20] + 1024 * 4096, 1024, 4096, O_W_1 + 8 * MiB)
            TJ(I10, P.in[21], 4096, 1024, O_W_2)
            TJ(I10, P.in[21] + 4096 * 1024, 4096, 1024, O_W_2 + 8 * MiB)
#undef TJ
        }
    }
    {
        float* cosT = (float*)(ws + O_COS); float* sinT = (float*)(ws + O_SIN);
        for (int idx = gw * 64 + lane; idx < 8192 * 32; idx += NGW * 64) {
            const int pos = idx >> 5, i = idx & 31;
            const float fr = exp2f(-(float)i * (13.287712379549449f / 32.f));
            const float ang = (float)pos * fr;
            cosT[idx] = cosf(ang); sinT[idx] = sinf(ang);
        }
    }
    for (int r = gw; r < 2 * NMR; r += NGW) {
        const int li = r / NMR, rr = r % NMR;
        const float* src = rr < 1024 ? P.in[2] + (size_t)rr * DM : P.in[3] + (size_t)(rr - 1024) * DM;
        f32x4 v[4];
#pragma unroll
        for (int j = 0; j < 4; ++j) v[j] = *(const f32x4*)(src + 4 * lane + 256 * j);
        norm_store_row(v, P.in[16] + li * DM, (bf16_t*)(ws + O_MEMN) + (size_t)r * DM, lane);
    }
    for (int r = gw; r < MT; r += NGW) {
        const float* src = r < MP ? P.in[0] + (size_t)r * DM : P.in[1] + (size_t)(r - MP) * DM;
        f32x4 v[4];
#pragma unroll
        for (int j = 0; j < 4; ++j) v[j] = *(const f32x4*)(src + 4 * lane + 256 * j);
#pragma unroll
        for (int j = 0; j < 4; ++j) *(f32x4*)(P.out + (size_t)r * DM + 4 * lane + 256 * j) = v[j];
        norm_store_row(v, P.in[4], (bf16_t*)(ws + O_XH) + (size_t)r * DM, lane);
    }
}

__device__ __forceinline__ void phase_resnorm(const Params& P, const float* __restrict__ ga, const float* __restrict__ gb, int gw, int NGW, int lane) {
    bf16_t* H = (bf16_t*)(P.ws + O_XH);
    for (int r = gw; r < MT; r += NGW) {
        f32x4 h[4], x[4]; float s = 0.f;
#pragma unroll
        for (int j = 0; j < 4; ++j) { const u32x2 w = *(const u32x2*)(H + (size_t)r * DM + 4 * lane + 256 * j);
            h[j] = (f32x4){bflo(w.x), bfhi(w.x), bflo(w.y), bfhi(w.y)};
            x[j] = *(const f32x4*)(P.out + (size_t)r * DM + 4 * lane + 256 * j);
            s += (h[j].x * h[j].x + h[j].y * h[j].y) + (h[j].z * h[j].z + h[j].w * h[j].w); }
        s = wave_sum(s);
        const float rs = 1.0f / sqrtf(s * (1.f / 1024.f) + EPS);
#pragma unroll
        for (int j = 0; j < 4; ++j) { const f32x4 gg = *(const f32x4*)(ga + 4 * lane + 256 * j);
            x[j] = x[j] + h[j] * rs * gg;
            *(f32x4*)(P.out + (size_t)r * DM + 4 * lane + 256 * j) = x[j]; }
        if (gb) norm_store_row(x, gb, H + (size_t)r * DM, lane);
    }
}

__device__ __forceinline__ void phase_cnorm(const Params& P, int gw, int NGW, int lane) {
    const bf16_t* C = (const bf16_t*)(P.ws + O_C);
    bf16_t* CNQ = (bf16_t*)(P.ws + O_CNQ); bf16_t* CNKV = (bf16_t*)(P.ws + O_CNKV); bf16_t* KR = (bf16_t*)(P.ws + O_KR);
    const float* cosT = (const float*)(P.ws + O_COS); const float* sinT = (const float*)(P.ws + O_SIN);
    const f32x4 gq = *(const f32x4*)(P.in[7] + 4 * lane), gk = *(const f32x4*)(P.in[8] + 4 * lane);
    for (int r = gw; r < MT; r += NGW) {
        const bf16_t* c = C + (size_t)r * 768;
        const u32x2 a = *(const u32x2*)(c + 4 * lane), b = *(const u32x2*)(c + 256 + 4 * lane);
        const float kr = __uint_as_float(((unsigned)c[512 + lane]) << 16);
        const f32x4 va = {bflo(a.x), bfhi(a.x), bflo(a.y), bfhi(a.y)}, vb = {bflo(b.x), bfhi(b.x), bflo(b.y), bfhi(b.y)};
        float sa = (va.x * va.x + va.y * va.y) + (va.z * va.z + va.w * va.w), sb = (vb.x * vb.x + vb.y * vb.y) + (vb.z * vb.z + vb.w * vb.w);
        sa = wave_sum(sa); sb = wave_sum(sb);
        const float ra = 1.0f / sqrtf(sa * (1.f / 256.f) + EPS), rb = 1.0f / sqrtf(sb * (1.f / 256.f) + EPS);
        u32x2 wa, wb;
        wa.x = cvtpk(va.x * ra * gq.x, va.y * ra * gq.y); wa.y = cvtpk(va.z * ra * gq.z, va.w * ra * gq.w);
        wb.x = cvtpk(vb.x * rb * gk.x, vb.y * rb * gk.y); wb.y = cvtpk(vb.z * rb * gk.z, vb.w * rb * gk.w);
        *(u32x2*)(CNQ + (size_t)r * 256 + 4 * lane) = wa;
        *(u32x2*)(CNKV + (size_t)r * 256 + 4 * lane) = wb;
        const int pos = tok_pos(r), i = lane & 31;
        const float cs = cosT[pos * 32 + i], sn = sinT[pos * 32 + i];
        const float pr = __shfl_xor(kr, 32);
        const float o = lane < 32 ? kr * cs - pr * sn : pr * sn + kr * cs;
        KR[(size_t)r * 64 + lane] = (bf16_t)(cvtpk(o, 0.f) & 0xffffu);
    }
}

namespace att {
constexpr int LDS_V = 0, LDS_K = 16384, LDS_WS = 49152, LDS_TAB = 51200, LDS_STASH = 53248;
__device__ __forceinline__ int crow(int r, int hi) { return (r & 3) + 8 * (r >> 2) + 4 * hi; }
#define SBAR() __builtin_amdgcn_sched_barrier(0)
__device__ __forceinline__ int v_st(int k, int c) { const int kk = (k & ~0xC) | ((k & 4) << 1) | ((k & 8) >> 1); return ((kk >> 3) * 4 + (c >> 5)) * 512 + ((kk & 7) * 32 + (c & 31)) * 2; }
__device__ __forceinline__ int v_rd_base(int lane) { return ((lane & 3) << 3) | (((lane >> 2) & 3) << 6) | (((lane >> 4) & 1) << 5) | (((lane >> 5) & 1) << 8); }
constexpr int v_rd_off(int d0, int ks, int half) { return d0 * 512 + ks * 4096 + half * 2048; }
template <int OFF> __device__ __forceinline__ s16x4 tr_read(int vb) {
    s16x4 r; asm volatile("ds_read_b64_tr_b16 %0, %1 offset:%2" : "=&v"(r) : "v"(vb), "i"(OFF) : "memory"); return r;
}
template <int D0> __device__ __forceinline__ void pv_one(f32x16& od, int vb, bf16x8 pa0, bf16x8 pa1, bf16x8 pa2, bf16x8 pa3) {
    const s16x4 l0 = tr_read<v_rd_off(D0, 0, 0)>(vb), h0 = tr_read<v_rd_off(D0, 0, 1)>(vb), l1 = tr_read<v_rd_off(D0, 1, 0)>(vb), h1 = tr_read<v_rd_off(D0, 1, 1)>(vb);
    const s16x4 l2 = tr_read<v_rd_off(D0, 2, 0)>(vb), h2 = tr_read<v_rd_off(D0, 2, 1)>(vb), l3 = tr_read<v_rd_off(D0, 3, 0)>(vb), h3 = tr_read<v_rd_off(D0, 3, 1)>(vb);
    asm volatile("s_waitcnt lgkmcnt(0)" ::: "memory"); SBAR();
#define PK(L, H) (bf16x8){L[0], L[1], L[2], L[3], H[0], H[1], H[2], H[3]}
    od = __builtin_amdgcn_mfma_f32_32x32x16_bf16(pa0, PK(l0, h0), od, 0, 0, 0);
    od = __builtin_amdgcn_mfma_f32_32x32x16_bf16(pa1, PK(l1, h1), od, 0, 0, 0);
    od = __builtin_amdgcn_mfma_f32_32x32x16_bf16(pa2, PK(l2, h2), od, 0, 0, 0);
    od = __builtin_amdgcn_mfma_f32_32x32x16_bf16(pa3, PK(l3, h3), od, 0, 0, 0);
#undef PK
}

template <int D0> __device__ __forceinline__ void pv_rd(s16x4 (&l)[4], s16x4 (&h)[4], int vb) {
    l[0] = tr_read<v_rd_off(D0, 0, 0)>(vb); h[0] = tr_read<v_rd_off(D0, 0, 1)>(vb); l[1] = tr_read<v_rd_off(D0, 1, 0)>(vb); h[1] = tr_read<v_rd_off(D0, 1, 1)>(vb);
    l[2] = tr_read<v_rd_off(D0, 2, 0)>(vb); h[2] = tr_read<v_rd_off(D0, 2, 1)>(vb); l[3] = tr_read<v_rd_off(D0, 3, 0)>(vb); h[3] = tr_read<v_rd_off(D0, 3, 1)>(vb);
}
__device__ __forceinline__ void pv_mm(f32x16& od, const s16x4 (&l)[4], const s16x4 (&h)[4], bf16x8 pa0, bf16x8 pa1, bf16x8 pa2, bf16x8 pa3) {
#define PK(L, H) (bf16x8){L[0], L[1], L[2], L[3], H[0], H[1], H[2], H[3]}
    od = __builtin_amdgcn_mfma_f32_32x32x16_bf16(pa0, PK(l[0], h[0]), od, 0, 0, 0);
    od = __builtin_amdgcn_mfma_f32_32x32x16_bf16(pa1, PK(l[1], h[1]), od, 0, 0, 0);
    od = __builtin_amdgcn_mfma_f32_32x32x16_bf16(pa2, PK(l[2], h[2]), od, 0, 0, 0);
    od = __builtin_amdgcn_mfma_f32_32x32x16_bf16(pa3, PK(l[3], h[3]), od, 0, 0, 0);
#undef PK
}
__device__ __forceinline__ void pv_all(f32x16 (&o)[4], int vb, bf16x8 pa0, bf16x8 pa1, bf16x8 pa2, bf16x8 pa3) {
    s16x4 la[4], ha[4], lb[4], hb[4];
    asm volatile("s_waitcnt lgkmcnt(0)" ::: "memory");
    pv_rd<0>(la, ha, vb); pv_rd<1>(lb, hb, vb);
    asm volatile("s_waitcnt lgkmcnt(8)" ::: "memory"); SBAR(); pv_mm(o[0], la, ha, pa0, pa1, pa2, pa3); SBAR();
    pv_rd<2>(la, ha, vb);
    asm volatile("s_waitcnt lgkmcnt(8)" ::: "memory"); SBAR(); pv_mm(o[1], lb, hb, pa0, pa1, pa2, pa3); SBAR();
    pv_rd<3>(lb, hb, vb);
    asm volatile("s_waitcnt lgkmcnt(8)" ::: "memory"); SBAR(); pv_mm(o[2], la, ha, pa0, pa1, pa2, pa3); SBAR();
    asm volatile("s_waitcnt lgkmcnt(0)" ::: "memory"); SBAR(); pv_mm(o[3], lb, hb, pa0, pa1, pa2, pa3); SBAR();
}

template <int DQK, bool MLAK, bool BIAS, bool PREFETCH>
__device__ __forceinline__ void attn_core(f32x16 (&o)[4], const bf16x8 (&qr)[DQK / 16],
                                          const bf16_t* __restrict__ Kg, int ldk, const bf16_t* __restrict__ K2g, const bf16_t* __restrict__ Vg, int ldv,
                                          int nkeys, float C, int qw0, LAS char* lds) {
    constexpr int PITCH = DQK * 2, CPR = DQK / 8, NKCH = DQK / 64;
    const int tid = otid(), wid = tid >> 6, lane = tid & 63, r32 = lane & 31, hi = lane >> 5;
    LAS char* V_lds = lds + LDS_V; LAS char* K_lds = lds + LDS_K;
    LAS float* wsf = (LAS float*)(lds + LDS_WS) + wid * 64; LAS float* li_l = wsf; LAS float* al_l = wsf + 32;
    const LAS float* tab = (const LAS float*)(lds + LDS_TAB);
    const int sr = tid >> 4, sc = (tid & 15) * 8, vst0 = v_st(sr, sc), vst1 = v_st(32 + sr, sc);
    const unsigned voff0 = (unsigned)(sr * ldv + sc), voff1 = (unsigned)((32 + sr) * ldv + sc);
    unsigned koff[NKCH]; int kdst[NKCH];
#pragma unroll
    for (int c = 0; c < NKCH; ++c) {
        int row, col;
        if (MLAK) { if (c < 2) { row = sr + 32 * c; col = sc; } else { row = tid >> 3; col = 128 + (tid & 7) * 8; } }
        else { const int id = tid + 512 * c; row = id / CPR; col = (id % CPR) * 8; }
        koff[c] = (MLAK && c == 2) ? (unsigned)(row * 64 + (col - 128)) : (unsigned)(row * ldk + col);
        kdst[c] = row * PITCH + ((col * 2) ^ ((row & 7) << 4)); }
    const int vb0 = (int)(unsigned)(uintptr_t)V_lds + v_rd_base(lane);
    const int kro = r32 * PITCH, kx = (r32 & 7) << 4;
    float m_reg = -1e30f, l_reg = 0.f;
#pragma unroll
    for (int d = 0; d < 4; ++d) o[d] = f32x16{};
    const int NT = nkeys / 64;
    bf16x8 vs0, vs1, ks[NKCH];
#define ATT_LOAD(t) do { const bf16_t* vt_ = Vg + (size_t)(t) * 64 * ldv; const bf16_t* kt_ = Kg + (size_t)(t) * 64 * ldk; const bf16_t* k2t_ = K2g + (size_t)(t) * 64 * 64; \
        vs0 = *(const bf16x8*)(vt_ + voff0); vs1 = *(const bf16x8*)(vt_ + voff1); \
        _Pragma("unroll") for (int c = 0; c < NKCH; ++c) ks[c] = *(const bf16x8*)(((MLAK && c == 2) ? k2t_ : kt_) + koff[c]); } while (0)
    if (PREFETCH) ATT_LOAD(0);
#pragma nounroll
    for (int j = 0; j < NT; ++j) {
        __syncthreads();
        if (!PREFETCH) ATT_LOAD(j);
        *(LAS bf16x8*)(V_lds + vst0) = vs0; *(LAS bf16x8*)(V_lds + vst1) = vs1;
#pragma unroll
        for (int c = 0; c < NKCH; ++c) *(LAS bf16x8*)(K_lds + kdst[c]) = ks[c];
        __syncthreads();
        if (PREFETCH && j + 1 < NT) ATT_LOAD(j + 1);
        f32x16 p0 = f32x16{}, p1 = f32x16{};
#pragma unroll
        for (int d0 = 0; d0 < DQK / 16; ++d0) { const int cb = ((d0 * 16 + hi * 8) * 2) ^ kx;
            const bf16x8 b0 = *(const LAS bf16x8*)(K_lds + kro + cb);
            const bf16x8 b1 = *(const LAS bf16x8*)(K_lds + kro + 32 * PITCH + cb);
            p0 = __builtin_amdgcn_mfma_f32_32x32x16_bf16(b0, qr[d0], p0, 0, 0, 0);
            p1 = __builtin_amdgcn_mfma_f32_32x32x16_bf16(b1, qr[d0], p1, 0, 0, 0); }
        if constexpr (BIAS) {
            const int kq = j * 64 - qw0;
            if (kq + 63 <= -128) { const float b = tab[0];
#pragma unroll
                for (int r = 0; r < 16; ++r) { p0[r] = fmaf(p0[r], C, b); p1[r] = fmaf(p1[r], C, b); } }
            else if (kq - 31 >= 128) { const float b = tab[256];
#pragma unroll
                for (int r = 0; r < 16; ++r) { p0[r] = fmaf(p0[r], C, b); p1[r] = fmaf(p1[r], C, b); } }
            else {
#pragma unroll
                for (int r = 0; r < 16; ++r) { const int i0 = kq + crow(r, hi) - r32 + 128;
                    const int a0 = min(max(i0, 0), 256), a1 = min(max(i0 + 32, 0), 256);
                    p0[r] = fmaf(p0[r], C, tab[a0]); p1[r] = fmaf(p1[r], C, tab[a1]); } }
        } else {
#pragma unroll
            for (int r = 0; r < 16; ++r) { p0[r] *= C; p1[r] *= C; }
        }
        float pmax = p0[0];
#pragma unroll
        for (int r = 1; r < 16; ++r) pmax = fmaxf(pmax, p0[r]);
#pragma unroll
        for (int r = 0; r < 16; ++r) pmax = fmaxf(pmax, p1[r]);
        { auto rr = __builtin_amdgcn_permlane32_swap(__float_as_uint(pmax), __float_as_uint(pmax), false, false);
          pmax = fmaxf(__uint_as_float(rr[0]), __uint_as_float(rr[1])); }
        const float mn = fmaxf(m_reg, pmax);
        const float alpha = __builtin_amdgcn_exp2f(m_reg - mn); m_reg = mn;
        float ps = 0.f;
#pragma unroll
        for (int r = 0; r < 16; ++r) { p0[r] = __builtin_amdgcn_exp2f(p0[r] - mn); p1[r] = __builtin_amdgcn_exp2f(p1[r] - mn); ps += p0[r] + p1[r]; }
        { auto rr = __builtin_amdgcn_permlane32_swap(__float_as_uint(ps), __float_as_uint(ps), false, false);
          ps = __uint_as_float(rr[0]) + __uint_as_float(rr[1]); }
        l_reg = l_reg * alpha + ps;
        if (__any(alpha < 1.f)) {
            if (hi == 0) al_l[r32] = alpha;
            asm volatile("s_waitcnt lgkmcnt(0)" ::: "memory");
#pragma unroll
            for (int r = 0; r < 16; ++r) { const float a = al_l[crow(r, hi)];
#pragma unroll
                for (int d = 0; d < 4; ++d) o[d][r] *= a; }
        }
        bf16x8 pa0, pa1, pa2, pa3;
#define PK4(P, BASE, OUT) do { unsigned a0 = cvtpk(P[BASE + 0], P[BASE + 1]), a1 = cvtpk(P[BASE + 2], P[BASE + 3]);   \
    unsigned b0 = cvtpk(P[BASE + 4], P[BASE + 5]), b1 = cvtpk(P[BASE + 6], P[BASE + 7]);                              \
    auto r0 = __builtin_amdgcn_permlane32_swap(a0, b0, false, false); auto r1 = __builtin_amdgcn_permlane32_swap(a1, b1, false, false); \
    u32x4 w = {r0[0], r1[0], r0[1], r1[1]}; OUT = *reinterpret_cast<bf16x8*>(&w); } while (0)
        PK4(p0, 0, pa0); PK4(p0, 8, pa1); PK4(p1, 0, pa2); PK4(p1, 8, pa3);
#undef PK4
        SBAR();
        pv_one<0>(o[0], vb0, pa0, pa1, pa2, pa3); pv_one<1>(o[1], vb0, pa0, pa1, pa2, pa3); pv_one<2>(o[2], vb0, pa0, pa1, pa2, pa3); pv_one<3>(o[3], vb0, pa0, pa1, pa2, pa3);
    }
    if (hi == 0) li_l[r32] = l_reg;
    asm volatile("s_waitcnt lgkmcnt(0)" ::: "memory");
#pragma unroll
    for (int r = 0; r < 16; ++r) { const float rl = 1.0f / li_l[crow(r, hi)];
#pragma unroll
        for (int d = 0; d < 4; ++d) o[d][r] *= rl; }
#undef ATT_LOAD
}

template <int DQK, bool MLAK, bool BIAS>
__device__ __forceinline__ void attn_core_pp(f32x16 (&o)[4], const bf16x8 (&qr)[DQK / 16],
                                             const bf16_t* __restrict__ Kg, int ldk, const bf16_t* __restrict__ K2g, const bf16_t* __restrict__ Vg, int ldv,
                                             int nkeys, float C, int qw0, LAS char* lds) {
    constexpr int PITCH = DQK * 2, KB = 64 * PITCH, CPR = DQK / 8, NKCH = DQK / 64;
    constexpr int L_V = 0, L_K = 49152, L_WS = L_K + 2 * KB, L_TAB = L_WS + 2048;
    const int tid = otid(), wid = tid >> 6, lane = tid & 63, r32 = lane & 31, hi = lane >> 5;
    const int grp = __builtin_amdgcn_readfirstlane(wid >> 2);
    LAS char* V_lds = lds + L_V; LAS char* K_lds = lds + L_K;
    LAS float* wsf = (LAS float*)(lds + L_WS) + wid * 64; LAS float* li_l = wsf; LAS float* al_l = wsf + 32;
    const LAS float* tab = (const LAS float*)(lds + L_TAB);
    const int sr = tid >> 4, sc = (tid & 15) * 8, vst0 = v_st(sr, sc), vst1 = v_st(32 + sr, sc);
    const unsigned voff0 = (unsigned)(sr * ldv + sc), voff1 = (unsigned)((32 + sr) * ldv + sc);
    unsigned koff[NKCH]; int kdst[NKCH];
#pragma unroll
    for (int c = 0; c < NKCH; ++c) {
        int row, col;
        if (MLAK) { if (c < 2) { row = sr + 32 * c; col = sc; } else { row = tid >> 3; col = 128 + (tid & 7) * 8; } }
        else { const int id = tid + 512 * c; row = id / CPR; col = (id % CPR) * 8; }
        koff[c] = (MLAK && c == 2) ? (unsigned)(row * 64 + (col - 128)) : (unsigned)(row * ldk + col);
        kdst[c] = row * PITCH + ((col * 2) ^ (((row >> 1) & 7) << 4)); }
    const int vb0 = (int)(unsigned)(uintptr_t)V_lds + v_rd_base(lane);
    const int kro = r32 * PITCH, kx = ((r32 >> 1) & 7) << 4;
    float m_reg = -1e30f, l_reg = 0.f;
#pragma unroll
    for (int d = 0; d < 4; ++d) o[d] = f32x16{};
    const int NT = nkeys / 64;
    bf16x8 vs0, vs1, ks[NKCH];
    f32x16 p0 = f32x16{}, p1 = f32x16{};
#define PP_LOAD(t) do { const bf16_t* vt_ = Vg + (size_t)(t) * 64 * ldv; const bf16_t* kt_ = Kg + (size_t)(t) * 64 * ldk; const bf16_t* k2t_ = K2g + (size_t)(t) * 64 * 64; \
        vs0 = *(const bf16x8*)(vt_ + voff0); vs1 = *(const bf16x8*)(vt_ + voff1); \
        _Pragma("unroll") for (int c = 0; c < NKCH; ++c) ks[c] = *(const bf16x8*)(((MLAK && c == 2) ? k2t_ : kt_) + koff[c]); } while (0)
#define PP_WRITE(t) do { LAS char* vd_ = V_lds + ((t) % 3) * 16384; LAS char* kd_ = K_lds + ((t) & 1) * KB; \
        *(LAS bf16x8*)(vd_ + vst0) = vs0; *(LAS bf16x8*)(vd_ + vst1) = vs1; \
        _Pragma("unroll") for (int c = 0; c < NKCH; ++c) *(LAS bf16x8*)(kd_ + kdst[c]) = ks[c]; } while (0)
#define PP_KRD(dst, d0_) do { const int cb_ = (((d0_) * 16 + hi * 8) * 2) ^ kx; dst[0] = *(const LAS bf16x8*)(kb_ + cb_); dst[1] = *(const LAS bf16x8*)(kb_ + 32 * PITCH + cb_); } while (0)
#define PP_QK(t) do { const LAS char* kb_ = K_lds + ((t) & 1) * KB + kro; p0 = f32x16{}; p1 = f32x16{}; \
        bf16x8 kfa[2], kfb[2], kfc[2]; PP_KRD(kfa, 0); PP_KRD(kfb, 1); \
        _Pragma("unroll") for (int d0 = 0; d0 < DQK / 16; ++d0) { \
            if (d0 + 2 < DQK / 16) { if (d0 % 3 == 0) PP_KRD(kfc, d0 + 2); else if (d0 % 3 == 1) PP_KRD(kfa, d0 + 2); else PP_KRD(kfb, d0 + 2); } \
            SBAR(); \
            if (d0 % 3 == 0) { p0 = __builtin_amdgcn_mfma_f32_32x32x16_bf16(kfa[0], qr[d0], p0, 0, 0, 0); p1 = __builtin_amdgcn_mfma_f32_32x32x16_bf16(kfa[1], qr[d0], p1, 0, 0, 0); } \
            else if (d0 % 3 == 1) { p0 = __builtin_amdgcn_mfma_f32_32x32x16_bf16(kfb[0], qr[d0], p0, 0, 0, 0); p1 = __builtin_amdgcn_mfma_f32_32x32x16_bf16(kfb[1], qr[d0], p1, 0, 0, 0); } \
            else { p0 = __builtin_amdgcn_mfma_f32_32x32x16_bf16(kfc[0], qr[d0], p0, 0, 0, 0); p1 = __builtin_amdgcn_mfma_f32_32x32x16_bf16(kfc[1], qr[d0], p1, 0, 0, 0); } \
            SBAR(); } } while (0)
#define PK4(P, BASE, OUT) do { unsigned a0 = cvtpk(P[BASE + 0], P[BASE + 1]), a1 = cvtpk(P[BASE + 2], P[BASE + 3]);   \
    unsigned b0 = cvtpk(P[BASE + 4], P[BASE + 5]), b1 = cvtpk(P[BASE + 6], P[BASE + 7]);                              \
    auto r0 = __builtin_amdgcn_permlane32_swap(a0, b0, false, false); auto r1 = __builtin_amdgcn_permlane32_swap(a1, b1, false, false); \
    u32x4 w = {r0[0], r1[0], r0[1], r1[1]}; OUT = *reinterpret_cast<bf16x8*>(&w); } while (0)
#define PP_SMPV(t) do { \
        float pmax; \
        if constexpr (BIAS) { const int kq = (t) * 64 - qw0; \
            if (kq + 63 <= -128) { const float b = tab[0]; _Pragma("unroll") for (int r = 0; r < 16; ++r) { p0[r] = fmaf(p0[r], C, b); p1[r] = fmaf(p1[r], C, b); } } \
            else if (kq - 31 >= 128) { const float b = tab[256]; _Pragma("unroll") for (int r = 0; r < 16; ++r) { p0[r] = fmaf(p0[r], C, b); p1[r] = fmaf(p1[r], C, b); } } \
            else { _Pragma("unroll") for (int r = 0; r < 16; ++r) { const int i0 = kq + crow(r, hi) - r32 + 128; const int a0 = min(max(i0, 0), 256), a1 = min(max(i0 + 32, 0), 256); \
                    p0[r] = fmaf(p0[r], C, tab[a0]); p1[r] = fmaf(p1[r], C, tab[a1]); } } } \
        pmax = fmaxf(p0[0], p1[0]); \
        _Pragma("unroll") for (int r = 1; r < 16; ++r) pmax = fmaxf(fmaxf(pmax, p0[r]), p1[r]); \
        { auto rr = __builtin_amdgcn_permlane32_swap(__float_as_uint(pmax), __float_as_uint(pmax), false, false); pmax = fmaxf(__uint_as_float(rr[0]), __uint_as_float(rr[1])); } \
        if constexpr (!BIAS) pmax *= C; \
        const float mn = fmaxf(m_reg, pmax); const float alpha = __builtin_amdgcn_exp2f(m_reg - mn); m_reg = mn; \
        float ps = 0.f; \
        if constexpr (BIAS) { _Pragma("unroll") for (int r = 0; r < 16; ++r) { p0[r] = __builtin_amdgcn_exp2f(p0[r] - mn); p1[r] = __builtin_amdgcn_exp2f(p1[r] - mn); ps += p0[r] + p1[r]; } } \
        else { _Pragma("unroll") for (int r = 0; r < 16; ++r) { p0[r] = __builtin_amdgcn_exp2f(fmaf(p0[r], C, -mn)); p1[r] = __builtin_amdgcn_exp2f(fmaf(p1[r], C, -mn)); ps += p0[r] + p1[r]; } } \
        { auto rr = __builtin_amdgcn_permlane32_swap(__float_as_uint(ps), __float_as_uint(ps), false, false); ps = __uint_as_float(rr[0]) + __uint_as_float(rr[1]); } \
        l_reg = l_reg * alpha + ps; \
        if (__any(alpha < 1.f)) { if (hi == 0) al_l[r32] = alpha; asm volatile("s_waitcnt lgkmcnt(0)" ::: "memory"); \
            _Pragma("unroll") for (int r = 0; r < 16; ++r) { const float a = al_l[crow(r, hi)]; _Pragma("unroll") for (int d = 0; d < 4; ++d) o[d][r] *= a; } } \
        bf16x8 pa0, pa1, pa2, pa3; PK4(p0, 0, pa0); PK4(p0, 8, pa1); PK4(p1, 0, pa2); PK4(p1, 8, pa3); SBAR(); \
        const int vb_ = vb0 + ((t) % 3) * 16384; \
        pv_all(o, vb_, pa0, pa1, pa2, pa3); } while (0)
    PP_LOAD(0);
    __syncthreads();
    PP_WRITE(0);
    if (NT > 1) PP_LOAD(1);
    __syncthreads();
#define PP_BAR() do { SBAR(); asm volatile("s_waitcnt lgkmcnt(0)\n\ts_barrier" ::: "memory"); SBAR(); } while (0)
    if (grp == 1) PP_BAR();
#pragma nounroll
    for (int j = 0; j < NT; ++j) {
        if (j + 1 < NT) { PP_WRITE(j + 1); if (j + 2 < NT) PP_LOAD(j + 2); }
        SBAR();
        PP_QK(j);
        PP_BAR();
        PP_SMPV(j);
        PP_BAR();
    }
    if (grp == 0) PP_BAR();
#undef PP_BAR
    if (hi == 0) li_l[r32] = l_reg;
    asm volatile("s_waitcnt lgkmcnt(0)" ::: "memory");
#pragma unroll
    for (int r = 0; r < 16; ++r) { const float rl = 1.0f / li_l[crow(r, hi)];
#pragma unroll
        for (int d = 0; d < 4; ++d) o[d][r] *= rl; }
#undef PP_LOAD
#undef PP_WRITE
#undef PP_QK
#undef PP_KRD
#undef PK4
#undef PP_SMPV
}

template <int DQK, bool MLAK, bool BIAS>
__device__ __forceinline__ void attn_core_sp(f32x16 (&o)[4], const bf16x8 (&qr)[DQK / 16],
                                             const bf16_t* __restrict__ Kg, int ldk, const bf16_t* __restrict__ K2g, const bf16_t* __restrict__ Vg, int ldv,
                                             int nkeys, float C, int qw0, LAS char* lds) {
    constexpr int PITCH = DQK * 2, KBY = 64 * PITCH, CPR = DQK / 8, NKCH = DQK / 64, ND0 = DQK / 16;
    constexpr int L_V = 0, L_K = 32768, L_WS = L_K + 2 * KBY, L_TAB = L_WS + 2048;
    const int tid = otid(), wid = tid >> 6, lane = tid & 63, r32 = lane & 31, hi = lane >> 5;
    LAS char* V_lds = lds + L_V; LAS char* K_lds = lds + L_K;
    LAS float* wsf = (LAS float*)(lds + L_WS) + wid * 64; LAS float* li_l = wsf; LAS float* al_l = wsf + 32;
    const LAS float* tab = (const LAS float*)(lds + L_TAB);
    const int sr = tid >> 4, sc = (tid & 15) * 8, vst0 = v_st(sr, sc), vst1 = v_st(32 + sr, sc);
    const unsigned voff0 = (unsigned)(sr * ldv + sc), voff1 = (unsigned)((32 + sr) * ldv + sc);
    unsigned koff[NKCH]; int kdst[NKCH];
#pragma unroll
    for (int c = 0; c < NKCH; ++c) {
        int row, col;
        if (MLAK) { if (c < 2) { row = sr + 32 * c; col = sc; } else { row = tid >> 3; col = 128 + (tid & 7) * 8; } }
        else { const int id = tid + 512 * c; row = id / CPR; col = (id % CPR) * 8; }
        koff[c] = (MLAK && c == 2) ? (unsigned)(row * 64 + (col - 128)) : (unsigned)(row * ldk + col);
        kdst[c] = row * PITCH + ((col * 2) ^ (((row >> 1) & 7) << 4)); }
    const int vb0 = (int)(unsigned)(uintptr_t)V_lds + v_rd_base(lane);
    const int kro = r32 * PITCH, kx = ((r32 >> 1) & 7) << 4;
    float m_reg = -1e30f, l_reg = 0.f;
#pragma unroll
    for (int d = 0; d < 4; ++d) o[d] = f32x16{};
    const int NT = nkeys / 64;
    bf16x8 vs0, vs1, ks[NKCH];
#define SP_LOAD(t) do { const bf16_t* vt_ = Vg + (size_t)(t) * 64 * ldv; const bf16_t* kt_ = Kg + (size_t)(t) * 64 * ldk; const bf16_t* k2t_ = K2g + (size_t)(t) * 64 * 64; \
        vs0 = *(const bf16x8*)(vt_ + voff0); vs1 = *(const bf16x8*)(vt_ + voff1); \
        _Pragma("unroll") for (int c = 0; c < NKCH; ++c) ks[c] = *(const bf16x8*)(((MLAK && c == 2) ? k2t_ : kt_) + koff[c]); } while (0)
#define SP_WRITE(b) do { LAS char* vd_ = V_lds + (b) * 16384; LAS char* kd_ = K_lds + (b) * KBY; \
        *(LAS bf16x8*)(vd_ + vst0) = vs0; *(LAS bf16x8*)(vd_ + vst1) = vs1; \
        _Pragma("unroll") for (int c = 0; c < NKCH; ++c) *(LAS bf16x8*)(kd_ + kdst[c]) = ks[c]; } while (0)
#define SP_QKT(P0, P1, b) do { const LAS char* kb_ = K_lds + (b) * KBY + kro; P0 = f32x16{}; P1 = f32x16{}; \
        _Pragma("unroll") for (int d0 = 0; d0 < ND0; ++d0) { const int cb = ((d0 * 16 + hi * 8) * 2) ^ kx; \
            const bf16x8 b0 = *(const LAS bf16x8*)(kb_ + cb); const bf16x8 b1 = *(const LAS bf16x8*)(kb_ + 32 * PITCH + cb); \
            P0 = __builtin_amdgcn_mfma_f32_32x32x16_bf16(b0, qr[d0], P0, 0, 0, 0); P1 = __builtin_amdgcn_mfma_f32_32x32x16_bf16(b1, qr[d0], P1, 0, 0, 0); } } while (0)
#define SP_PART(P0, P1, ALPHA, t) do { \
        if constexpr (BIAS) { const int kq = (t) * 64 - qw0; \
            if (kq + 63 <= -128) { const float b = tab[0]; _Pragma("unroll") for (int r = 0; r < 16; ++r) { P0[r] = fmaf(P0[r], C, b); P1[r] = fmaf(P1[r], C, b); } } \
            else if (kq - 31 >= 128) { const float b = tab[256]; _Pragma("unroll") for (int r = 0; r < 16; ++r) { P0[r] = fmaf(P0[r], C, b); P1[r] = fmaf(P1[r], C, b); } } \
            else { _Pragma("unroll") for (int r = 0; r < 16; ++r) { const int i0 = kq + crow(r, hi) - r32 + 128; const int a0 = min(max(i0, 0), 256), a1 = min(max(i0 + 32, 0), 256); \
                    P0[r] = fmaf(P0[r], C, tab[a0]); P1[r] = fmaf(P1[r], C, tab[a1]); } } } \
        float pmax = P0[0]; _Pragma("unroll") for (int r = 1; r < 16; ++r) pmax = fmaxf(pmax, P0[r]); _Pragma("unroll") for (int r = 0; r < 16; ++r) pmax = fmaxf(pmax, P1[r]); \
        { auto rr = __builtin_amdgcn_permlane32_swap(__float_as_uint(pmax), __float_as_uint(pmax), false, false); pmax = fmaxf(__uint_as_float(rr[0]), __uint_as_float(rr[1])); } \
        const float KS = BIAS ? 1.0f : C;                   \
        float mn; \
        if (__builtin_expect(__all((pmax - m_reg) * KS <= 8.f * LOG2E), 1)) { mn = m_reg; ALPHA = 1.f; } \
        else { mn = fmaxf(m_reg, pmax); ALPHA = __builtin_amdgcn_exp2f((m_reg - mn) * KS); m_reg = mn; } \
        const float mnC = -mn * KS; \
        if constexpr (BIAS) { _Pragma("unroll") for (int r = 0; r < 16; ++r) { P0[r] += mnC; P1[r] += mnC; } } \
        else { _Pragma("unroll") for (int r = 0; r < 16; ++r) { P0[r] = fmaf(P0[r], C, mnC); P1[r] = fmaf(P1[r], C, mnC); } } \
        _Pragma("unroll") for (int r = 0; r < 16; ++r) P0[r] = __builtin_amdgcn_exp2f(P0[r]); } while (0)
#define PK4(P, BASE, OUT) do { unsigned a0 = cvtpk(P[BASE + 0], P[BASE + 1]), a1 = cvtpk(P[BASE + 2], P[BASE + 3]);   \
    unsigned b0 = cvtpk(P[BASE + 4], P[BASE + 5]), b1 = cvtpk(P[BASE + 6], P[BASE + 7]);                              \
    auto r0 = __builtin_amdgcn_permlane32_swap(a0, b0, false, false); auto r1 = __builtin_amdgcn_permlane32_swap(a1, b1, false, false); \
    u32x4 w = {r0[0], r1[0], r0[1], r1[1]}; OUT = *reinterpret_cast<bf16x8*>(&w); } while (0)
#define SP_FIN(P0, P1, ALPHA) do { \
        _Pragma("unroll") for (int r = 0; r < 16; ++r) P1[r] = __builtin_amdgcn_exp2f(P1[r]); \
        float ps = 0.f; _Pragma("unroll") for (int r = 0; r < 16; ++r) ps += P0[r]; _Pragma("unroll") for (int r = 0; r < 16; ++r) ps += P1[r]; \
        { auto rr = __builtin_amdgcn_permlane32_swap(__float_as_uint(ps), __float_as_uint(ps), false, false); ps = __uint_as_float(rr[0]) + __uint_as_float(rr[1]); } \
        l_reg = l_reg * ALPHA + ps; \
        PK4(P0, 0, pa0); PK4(P0, 8, pa1); PK4(P1, 0, pa2); PK4(P1, 8, pa3); } while (0)
#define SP_PV(b) do { const int vb_ = vb0 + (b) * 16384; \
        pv_one<0>(o[0], vb_, pa0, pa1, pa2, pa3); pv_one<1>(o[1], vb_, pa0, pa1, pa2, pa3); pv_one<2>(o[2], vb_, pa0, pa1, pa2, pa3); pv_one<3>(o[3], vb_, pa0, pa1, pa2, pa3); } while (0)
#define SP_RESC(a) do { if (__any((a) < 1.f)) { if (hi == 0) al_l[r32] = (a); asm volatile("s_waitcnt lgkmcnt(0)" ::: "memory"); \
        _Pragma("unroll") for (int r = 0; r < 16; ++r) { const float a_ = al_l[crow(r, hi)]; _Pragma("unroll") for (int d = 0; d < 4; ++d) o[d][r] *= a_; } } } while (0)
    f32x16 pA0, pA1, pB0, pB1; float alA, alB; bf16x8 pa0, pa1, pa2, pa3;
    SP_LOAD(0); __syncthreads(); SP_WRITE(0); __syncthreads();
    SP_QKT(pA0, pA1, 0); SP_PART(pA0, pA1, alA, 0);
    SP_LOAD(1); SP_WRITE(1); __syncthreads();
#pragma nounroll
    for (int j = 1; j + 1 < NT; j += 2) {
        SBAR(); SP_QKT(pB0, pB1, 1);
        SP_FIN(pA0, pA1, alA); SBAR();
        SP_LOAD(j + 1); SBAR();
        SP_PV(0); SP_PART(pB0, pB1, alB, j);
        __syncthreads(); SP_WRITE(0);
        SP_RESC(alB); __syncthreads();
        SBAR(); SP_QKT(pA0, pA1, 0);
        SP_FIN(pB0, pB1, alB); SBAR();
        SP_LOAD(j + 2); SBAR();
        SP_PV(1); SP_PART(pA0, pA1, alA, j + 1);
        __syncthreads(); SP_WRITE(1);
        SP_RESC(alA); __syncthreads();
    }
    SBAR(); SP_QKT(pB0, pB1, 1);
    SP_FIN(pA0, pA1, alA); SBAR();
    SP_PV(0); SP_PART(pB0, pB1, alB, NT - 1);
    SP_RESC(alB);
    SP_FIN(pB0, pB1, alB); SBAR();
    SP_PV(1);
    if (hi == 0) li_l[r32] = l_reg;
    asm volatile("s_waitcnt lgkmcnt(0)" ::: "memory");
#pragma unroll
    for (int r = 0; r < 16; ++r) { const float rl = 1.0f / li_l[crow(r, hi)];
#pragma unroll
        for (int d = 0; d < 4; ++d) o[d][r] *= rl; }
#undef SP_LOAD
#undef SP_WRITE
#undef SP_QKT
#undef SP_PART
#undef PK4
#undef SP_FIN
#undef SP_PV
#undef SP_RESC
}

__device__ __forceinline__ void store_o(const f32x16 (&o)[4], bf16_t* Ob, int ldo, int r32, int hi) {
#pragma unroll
    for (int r = 0; r < 16; ++r) { bf16_t* p = Ob + (size_t)crow(r, hi) * ldo + r32;
#pragma unroll
        for (int d0 = 0; d0 < 4; ++d0) p[d0 * 32] = (bf16_t)(cvtpk(o[d0][r], 0.f) & 0xffffu); }
}
}

__device__ __forceinline__ void self_unit(int u, int& seqbase, int& S, int& h, int& qb) {
    if (u < 2048) { const int round = u >> 8, v = u & 255, x = v >> 5, j = v & 31; const int pair = x * 8 + round; S = SS; seqbase = MP + (pair >> 3) * SS; h = pair & 7; qb = j; }
    else { const int u2 = u - 2048, round = u2 >> 8, v = u2 & 255, x = v >> 5, j = v & 31; const int pair = x * 4 + round * 2 + (j >> 4); S = SP; seqbase = (pair >> 3) * SP; h = pair & 7; qb = j & 15; }
}

__device__ __forceinline__ void phase_mla_attn(const Params& P, LAS char* lds, int vcu, int G) {
    const int tid = otid(), wid = tid >> 6, lane = tid & 63, r32 = lane & 31, hi = lane >> 5;
    const bf16_t* Q = (const bf16_t*)(P.ws + O_Q); const bf16_t* KV = (const bf16_t*)(P.ws + O_KV); const bf16_t* KR = (const bf16_t*)(P.ws + O_KR);
    bf16_t* O = (bf16_t*)(P.ws + O_O);
    const float* cosT = (const float*)(P.ws + O_COS); const float* sinT = (const float*)(P.ws + O_SIN);
    const float C = 0.07216878364870323f * LOG2E;
#pragma nounroll
    for (int u = vcu; u < 2560; u += G) {
        int seqbase, S, h, qb; self_unit(u, seqbase, S, h, qb);
        const int pos = qb * 256 + wid * 32 + r32; const size_t row = (size_t)seqbase + pos;
        const bf16_t* qp = Q + row * 1536 + h * 192 + hi * 8;
        bf16x8 qr[12];
#pragma unroll
        for (int d0 = 0; d0 < 12; ++d0) qr[d0] = *(const bf16x8*)(qp + d0 * 16);
#pragma unroll
        for (int pr = 0; pr < 2; ++pr) { const int i0 = pr * 16 + hi * 8;
            const f32x4 c0 = *(const f32x4*)(cosT + pos * 32 + i0), c1 = *(const f32x4*)(cosT + pos * 32 + i0 + 4);
            const f32x4 s0 = *(const f32x4*)(sinT + pos * 32 + i0), s1 = *(const f32x4*)(sinT + pos * 32 + i0 + 4);
            const float cs[8] = {c0.x, c0.y, c0.z, c0.w, c1.x, c1.y, c1.z, c1.w}, sn[8] = {s0.x, s0.y, s0.z, s0.w, s1.x, s1.y, s1.z, s1.w};
            const bf16x8 x1 = qr[8 + pr], x2 = qr[10 + pr]; float o1[8], o2[8];
#pragma unroll
            for (int e = 0; e < 8; ++e) { const float a = bf1(x1[e]), b = bf1(x2[e]); o1[e] = a * cs[e] - b * sn[e]; o2[e] = a * sn[e] + b * cs[e]; }
            u32x4 w1 = {cvtpk(o1[0], o1[1]), cvtpk(o1[2], o1[3]), cvtpk(o1[4], o1[5]), cvtpk(o1[6], o1[7])};
            u32x4 w2 = {cvtpk(o2[0], o2[1]), cvtpk(o2[2], o2[3]), cvtpk(o2[4], o2[5]), cvtpk(o2[6], o2[7])};
            qr[8 + pr] = __builtin_bit_cast(bf16x8, w1); qr[10 + pr] = __builtin_bit_cast(bf16x8, w2); }
        f32x16 o[4];
        att::attn_core_pp<192, true, false>(o, qr, KV + (size_t)seqbase * 2048 + h * 256, 2048, KR + (size_t)seqbase * 64, KV + (size_t)seqbase * 2048 + h * 256 + 128, 2048, S, C, 0, lds);
        att::store_o(o, O + ((size_t)seqbase + qb * 256 + wid * 32) * 1024 + h * 128, 1024, r32, hi);
    }
}

__device__ __forceinline__ void phase_xattn(const Params& P, int layer, LAS char* lds, int vcu, int G) {
    const int tid = otid(), wid = tid >> 6, lane = tid & 63, r32 = lane & 31, hi = lane >> 5;
    const bf16_t* XQ = (const bf16_t*)(P.ws + O_XQ); const bf16_t* MKV = (const bf16_t*)(P.ws + O_MKV) + (size_t)layer * NMR * 2048;
    bf16_t* O = (bf16_t*)(P.ws + O_O);
    const float C = 0.0625f * LOG2E;
#pragma nounroll
    for (int u = vcu; u < 2560; u += G) {
        const int vh = u & 1, h = (u >> 1) & 3, t = u >> 3; const int tok0 = t * 256;
        const int batch = tok0 < MP ? tok0 / SP : 4 + (tok0 - MP) / SS;
        const size_t row = (size_t)tok0 + wid * 32 + r32;
        const bf16_t* qp = XQ + row * 1024 + h * 256 + hi * 8;
        bf16x8 qr[16];
#pragma unroll
        for (int d0 = 0; d0 < 16; ++d0) qr[d0] = *(const bf16x8*)(qp + d0 * 16);
        const bf16_t* kb = MKV + (size_t)batch * 256 * 2048 + h * 256;
        f32x16 o[4];
        att::attn_core<256, false, false, false>(o, qr, kb, 2048, nullptr, kb + 1024 + vh * 128, 2048, 256, C, 0, lds);
        att::store_o(o, O + ((size_t)tok0 + wid * 32) * 1024 + h * 256 + vh * 128, 1024, r32, hi);
    }
}

__device__ __forceinline__ void phase_diff_attn(const Params& P, LAS char* lds, int vcu, int G) {
    const int tid = otid(), wid = tid >> 6, lane = tid & 63, r32 = lane & 31, hi = lane >> 5;
    const bf16_t* QKV = (const bf16_t*)(P.ws + O_QKV); bf16_t* O = (bf16_t*)(P.ws + O_O);
    const float* lam = P.in[13]; const float* subln = P.in[14]; const float* rbt = P.in[5];
    const float la = wave_sum(lam[lane] * lam[64 + lane]), lb = wave_sum(lam[128 + lane] * lam[192 + lane]);
    const float lam_full = expf(la) - expf(lb) + LAMBDA_INIT;
    const float C = 0.125f * LOG2E;
    LAS float* tab = (LAS float*)(lds + 51200);
    float sg[4];
#pragma unroll
    for (int d0 = 0; d0 < 4; ++d0) sg[d0] = subln[d0 * 32 + r32] * (1.0f - LAMBDA_INIT);
#pragma nounroll
    for (int u = vcu; u < 2560; u += G) {
        int seqbase, S, h, qb; self_unit(u, seqbase, S, h, qb);
        __syncthreads();
        for (int idx = tid; idx < 257; idx += 512) { const int rel = idx - 128, n = rel < 0 ? -rel : rel;
            int b = n < 8 ? n : (n < 12 ? 8 : n < 16 ? 9 : n < 23 ? 10 : n < 32 ? 11 : n < 46 ? 12 : n < 64 ? 13 : n < 91 ? 14 : 15);
            if (rel > 0) b += 16;
            tab[idx] = rbt[b * 8 + h] * LOG2E; }
        const int qw0 = qb * 256 + wid * 32; const size_t row = (size_t)seqbase + qw0 + r32;
        const bf16_t* base = QKV + (size_t)seqbase * 3072;
        f32x16 oa[4], ob[4];
        LAS unsigned* stash = (LAS unsigned*)(lds + 53248) + tid;
        { bf16x8 qr[4]; const bf16_t* qp = QKV + row * 3072 + h * 128 + hi * 8;
#pragma unroll
          for (int d0 = 0; d0 < 4; ++d0) qr[d0] = *(const bf16x8*)(qp + d0 * 16);
          att::attn_core_sp<64, false, true>(oa, qr, base + 1024 + h * 128, 3072, nullptr, base + 2048 + h * 128, 3072, S, C, qw0, lds); }
#pragma unroll
        for (int d0 = 0; d0 < 4; ++d0)
#pragma unroll
            for (int r = 0; r < 16; r += 2) stash[(d0 * 8 + (r >> 1)) * 512] = cvtpk(oa[d0][r], oa[d0][r + 1]);
        { bf16x8 qr[4]; const bf16_t* qp = QKV + row * 3072 + h * 128 + 64 + hi * 8;
#pragma unroll
          for (int d0 = 0; d0 < 4; ++d0) qr[d0] = *(const bf16x8*)(qp + d0 * 16);
          att::attn_core_sp<64, false, true>(ob, qr, base + 1024 + h * 128 + 64, 3072, nullptr, base + 2048 + h * 128, 3072, S, C, qw0, lds); }
#pragma unroll
        for (int r = 0; r < 16; ++r) { float s = 0.f;
#pragma unroll
            for (int d0 = 0; d0 < 4; ++d0) { const unsigned w = stash[(d0 * 8 + (r >> 1)) * 512]; const float a = (r & 1) ? bfhi(w) : bflo(w); const float v = a - lam_full * ob[d0][r]; oa[d0][r] = v; s += v * v; }
            s += __shfl_xor(s, 1); s += __shfl_xor(s, 2); s += __shfl_xor(s, 4); s += __shfl_xor(s, 8); s += __shfl_xor(s, 16);
            const float rs = 1.0f / sqrtf(s * (1.f / 128.f) + EPS);
#pragma unroll
            for (int d0 = 0; d0 < 4; ++d0) oa[d0][r] *= rs * sg[d0]; }
        att::store_o(oa, O + ((size_t)seqbase + qw0) * 1024 + h * 128, 1024, r32, hi);
    }
}

struct GemmDesc { const bf16_t* A; const bf16_t* Bt; bf16_t* C; int M, N, K, act; };
__device__ __forceinline__ int gemm_desc(int ph, int sub, unsigned char* ws, GemmDesc& d) {
#define BP(off) ((bf16_t*)(ws + (off)))
    const int L = ph >= 14 ? 1 : 0;
    switch (ph) {
    case 1:
        if (sub < 2) { d = GemmDesc{BP(O_MEMN) + (size_t)sub * NMR * 1024, BP(O_W_XKV + (size_t)sub * 4 * MiB), BP(O_MKV) + (size_t)sub * NMR * 2048, NMR, 2048, 1024, 0}; }
        else { d = GemmDesc{BP(O_XH), BP(O_W_MLA_IN), BP(O_C), MT, 768, 1024, 0}; }
        return 3;
    case 3:
        if (sub == 0) d = GemmDesc{BP(O_CNQ), BP(O_W_MLA_UQ), BP(O_Q), MT, 1536, 256, 0};
        else d = GemmDesc{BP(O_CNKV), BP(O_W_MLA_UKV), BP(O_KV), MT, 2048, 256, 0};
        return 2;
    case 5: d = GemmDesc{BP(O_O), BP(O_W_MLA_O), BP(O_XH), MT, 1024, 1024, 0}; return 1;
    case 7: case 18: d = GemmDesc{BP(O_XH), BP(O_W_XQ + (size_t)L * 2 * MiB), BP(O_XQ), MT, 1024, 1024, 0}; return 1;
    case 9: case 20: d = GemmDesc{BP(O_O), BP(O_W_XO + (size_t)L * 2 * MiB), BP(O_XH), MT, 1024, 1024, 0}; return 1;
    case 11: case 22: d = GemmDesc{BP(O_XH), BP(O_W_1 + (size_t)L * 8 * MiB), BP(O_ACT), MT, 4096, 1024, 1}; return 1;
    case 12: case 23: d = GemmDesc{BP(O_ACT), BP(O_W_2 + (size_t)L * 8 * MiB), BP(O_XH), MT, 1024, 4096, 0}; return 1;
    case 14: d = GemmDesc{BP(O_XH), BP(O_W_DIFF_IN), BP(O_QKV), MT, 3072, 1024, 0}; return 1;
    case 16: d = GemmDesc{BP(O_O), BP(O_W_DIFF_O), BP(O_XH), MT, 1024, 1024, 0}; return 1;
    default: return 0;
    }
#undef BP
}

__global__ void __launch_bounds__(512, 2) mk_fwd(Params P) {
    extern __shared__ __attribute__((aligned(16))) unsigned char lds_raw[];
    cg::grid_group grid = cg::this_grid();
    LAS unsigned char* lds = (LAS unsigned char*)lds_raw;
    const int G = gridDim.x, bx = blockIdx.x;
    const int vcu = (G % 8 == 0) ? (bx % 8) * (G / 8) + bx / 8 : bx;
    const int NGW = G * 8;
    const float* gains = P.in[4];
    int rep = 0;
#pragma nounroll
    for (int ph = 0; ph < NPH_LIMIT;) {
        const int tid = otid(), lane = tid & 63, wave = __builtin_amdgcn_readfirstlane(tid >> 6);
        const int gw = vcu * 8 + wave;
        if (ph == 0) phase_prologue(P, lds, gw, NGW, wave, lane);
        else if (ph == 2) phase_cnorm(P, gw, NGW, lane);
#ifndef SKIP_MLA
        else if (ph == 4) phase_mla_attn(P, (LAS char*)lds, vcu, G);
#endif
#ifndef SKIP_DIFF
        else if (ph == 15) phase_diff_attn(P, (LAS char*)lds, vcu, G);
#endif
#ifndef SKIP_XATTN
        else if (ph == 8 || ph == 19) phase_xattn(P, ph == 8 ? 0 : 1, (LAS char*)lds, vcu, G);
#endif
        else if (ph == 6 || ph == 10 || ph == 13 || ph == 17 || ph == 21 || ph == 24) {
            const int L = ph >= 14 ? 1 : 0; const int k = (ph == 6 || ph == 17) ? 1 : (ph == 10 || ph == 21) ? 3 : 5;
            const float* ga = gains + (L * 6 + k) * DM;
            const float* gb = (k < 5) ? gains + (L * 6 + k + 1) * DM : (L == 0 ? gains + 6 * DM : nullptr);
            phase_resnorm(P, ga, gb, gw, NGW, lane);
        } else {
            GemmDesc d; const int n = gemm_desc(ph, 0, P.ws, d);
#pragma nounroll
            for (int sub = 0; sub < n; ++sub) {
                gemm_desc(ph, sub, P.ws, d);
                pg8::Gemm g{d.A, d.Bt, d.M, d.N, d.K}; pg8::StaticOrder S; S.init(d.M, d.N, G, bx);
                pg8::EpiRt E{d.C, d.N, d.act};
#ifndef SKIP_GEMM
                pg8::gemm_phase<pg8::EpiRt, pg8::StaticOrder, true, true>(lds, g, S, E);
#endif
                __syncthreads();
            }
        }
        grid.sync();
        if (((REPEAT_MASK >> ph) & 1u) && rep == 0) rep = 1; else { rep = 0; ++ph; }
    }
}

extern "C" void kernel_launch(void* const* d_in, const int* in_sizes, int n_in, void* d_out, int out_size, void* d_ws, size_t ws_size, hipStream_t stream) {
    static int grid = 0;
    if (grid == 0) {
        if (n_in != 22 || out_size != MT * DM || ws_size < WS_END) {
            fprintf(stderr, "kernel_launch: unexpected shapes: n_in %d out %d ws %zu (need %zu)\n", n_in, out_size, ws_size, (size_t)WS_END); grid = -1; return; }
        int dev = 0, cus = 0, per_cu = 0;
        if (hipGetDevice(&dev) != hipSuccess || hipDeviceGetAttribute(&cus, hipDeviceAttributeMultiprocessorCount, dev) != hipSuccess) { fprintf(stderr, "kernel_launch: device query failed\n"); grid = -1; return; }
        if (hipFuncSetAttribute((const void*)mk_fwd, hipFuncAttributeMaxDynamicSharedMemorySize, LDS_BYTES) != hipSuccess) { fprintf(stderr, "kernel_launch: hipFuncSetAttribute failed\n"); grid = -1; return; }
        if (hipOccupancyMaxActiveBlocksPerMultiprocessor(&per_cu, (const void*)mk_fwd, 512, LDS_BYTES) != hipSuccess || per_cu < 1) { fprintf(stderr, "kernel_launch: occupancy query gave %d\n", per_cu); per_cu = 1; (void)hipGetLastError(); }
        grid = cus * per_cu;
    }
    if (grid < 0) return;
    Params p{};
    for (int i = 0; i < 22; ++i) p.in[i] = (const float*)d_in[i];
    p.out = (float*)d_out; p.ws = (unsigned char*)d_ws;
    void* args[] = {&p};
    hipError_t e = hipLaunchCooperativeKernel((const void*)mk_fwd, dim3(grid), dim3(512), args, LDS_BYTES, stream);
    if (e != hipSuccess) fprintf(stderr, "kernel_launch: cooperative launch failed: %s (grid %d)\n", hipGetErrorString(e), grid);
}
```

```cpp
#include <hip/hip_runtime.h>
#include <hip/hip_cooperative_groups.h>
#include <cstdio>
#include <cstdint>
namespace cg = cooperative_groups;
namespace pg8 {
#define PG8_LAS __attribute__((address_space(3)))
typedef unsigned short bf16_t;
typedef short bf16x8 __attribute__((ext_vector_type(8)));
typedef float f32x4 __attribute__((ext_vector_type(4)));
typedef unsigned u32x4 __attribute__((ext_vector_type(4)));
constexpr int BM = 256, BK = 64, HALF = 128, HTB = HALF * BK * 2  , STAGE_BYTES = 8 * HTB, NXCD = 8, WGM = 8;

__host__ __device__ __forceinline__ int lds_byte(int r, int c) { const int st = (r >> 4) * 2 + (c >> 5), rr = r & 15, cc = c & 31, ob = rr * 64 + cc * 2; return st * 1024 + (ob ^ (((ob >> 9) & 1) << 5)); }
__host__ __device__ __forceinline__ void stage_rc(int b, int& R, int& C) { const int st = b / 1024, sb = b % 1024, swz = sb ^ (((sb >> 9) & 1) << 5); R = (st >> 1) * 16 + swz / 64; C = (st & 1) * 32 + (swz % 64) / 2; }
__host__ __device__ __forceinline__ int perm32(int rho) { const int n = rho >> 4, i = rho & 15; return 8 * (i >> 2) + 4 * n + (i & 3); }

struct Unit { int pm, pn; };
struct Gemm { const bf16_t* A; const bf16_t* Bt; int M, N, K; };

struct StaticOrder {
    int nM, nN, nwg, G, c;
    __host__ __device__ void init(int M, int N, int G_, int c_) { nM = M / BM; nN = N / BM; nwg = nM * nN; G = G_; c = c_; }
    __host__ __device__ bool next(int i, Unit& u) const {
        const long L = (long)i * G + c; if (L >= nwg) return false;
        int wgid = (int)L; { const int q = nwg / NXCD, r = nwg % NXCD, xcd = wgid % NXCD, off = wgid / NXCD; wgid = (xcd < r ? xcd * (q + 1) : r * (q + 1) + (xcd - r) * q) + off; }
        const int nig = WGM * nN, gid = wgid / nig, fm = gid * WGM, gsz = (nM - fm) < WGM ? (nM - fm) : WGM;
        u.pm = fm + ((wgid % nig) % gsz); u.pn = (wgid % nig) / gsz; return true;
    }
    __device__ __forceinline__ void a_ready(const Unit&) const {}
    __device__ __forceinline__ void done(const Unit&) const {}
};

__device__ __forceinline__ unsigned cvt_pk_bf16(float lo, float hi) { unsigned r; asm volatile("v_cvt_pk_bf16_f32 %0, %1, %2" : "=v"(r) : "v"(lo), "v"(hi)); return r; }
typedef float f32x2 __attribute__((ext_vector_type(2)));
struct EpiRt {
    static constexpr bool PERM = true, AFTER_DRAIN = false;
    bf16_t* O; int ldc; int act; int mode; bf16_t* O2; bf16_t* O3;
    __device__ __forceinline__ void operator()(const f32x4 (&acc)[2][2][4][2], const Unit& u, int wr, int wc, int fr, int fq) const {
        const int row0 = u.pm * BM + wr * 64 + fr; const int col0 = u.pn * BM + wc * 32 + 8 * fq;
#pragma unroll
        for (int ai = 0; ai < 2; ++ai)
#pragma unroll
            for (int m = 0; m < 4; ++m) { const size_t row = (size_t)(row0 + ai * HALF + m * 16);
                bf16_t* rowp = O + row * ldc + col0;
                bf16_t* p0 = rowp; bf16_t* p1 = rowp + HALF;
                if (mode == 1) { p0 = O2 + ((size_t)u.pn * 81920 + row) * 192 + wc * 32 + 8 * fq; p1 = O3 + ((size_t)u.pn * 81920 + row) * 128 + wc * 32 + 8 * fq; }
                else if (mode == 2 && u.pn >= 4) { bf16_t* hb = u.pn >= 8 ? O3 : O2; const int h0 = 2 * (u.pn & 3);
                    p0 = hb + ((size_t)h0 * 81920 + row) * 128 + wc * 32 + 8 * fq; p1 = hb + ((size_t)(h0 + 1) * 81920 + row) * 128 + wc * 32 + 8 * fq; }
#pragma unroll
                for (int bj = 0; bj < 2; ++bj) { f32x4 v0 = acc[ai][bj][m][0], v1 = acc[ai][bj][m][1];
                    if (act) {
#pragma unroll
                        for (int e = 0; e < 4; ++e) { float a = fmaxf(v0[e], 0.f), b = fmaxf(v1[e], 0.f); v0[e] = a * a; v1[e] = b * b; } }
                    u32x4 w; w.x = cvt_pk_bf16(v0[0], v0[1]); w.y = cvt_pk_bf16(v0[2], v0[3]); w.z = cvt_pk_bf16(v1[0], v1[1]); w.w = cvt_pk_bf16(v1[2], v1[3]);
                    *(u32x4*)(bj ? p1 : p0) = w; } }
    }
};
template <class Epi, class Sched, bool ALIGN_EPI = false, bool SP2 = false>
__device__ __forceinline__ void gemm_phase(PG8_LAS unsigned char* lds, const Gemm g, const Sched& S, const Epi& E) {
    int tid_ = threadIdx.x; asm volatile("" : "+v"(tid_)); const int tid = tid_, wid = __builtin_amdgcn_readfirstlane(tid >> 6), lane = tid & 63, wr = wid >> 2, wc = wid & 3, fr = lane & 15, fq = lane >> 4;
    const int K = g.K, nt = K / BK;
    unsigned voffA[2], voffB[2];
#pragma unroll
    for (int i = 0; i < 2; ++i) { int R, C; stage_rc(tid * 16 + i * 8192, R, C); const int Rb = Epi::PERM ? ((R & ~31) + perm32(R & 31)) : R;
        voffA[i] = (unsigned)(R * K + C) * 2u; voffB[i] = (unsigned)(Rb * K + C) * 2u; }
    const size_t kstep = (size_t)(BK * 2);
    const size_t hstep = (size_t)HALF * K * 2;
    const size_t tstep = 2 * hstep;
    const unsigned ldsw = (unsigned)wid * 1024u;
    const int aoff = lds_byte(wr * 64 + fr, fq * 8), boff = lds_byte(wc * 32 + fr, fq * 8);
#define PG8_SA(b, h) (((b) * 2 + (h)) * HTB)
#define PG8_SB(b, h) ((4 + (b) * 2 + (h)) * HTB)
#define PG8_STAGE(bufoff, gbase, voff) do { _Pragma("unroll") for (int _i = 0; _i < 2; ++_i) \
        __builtin_amdgcn_global_load_lds((const unsigned*)((const char*)(gbase) + (voff)[_i]), (PG8_LAS unsigned*)(lds + (bufoff) + ldsw + _i * 8192), 16, 0, 0); } while (0)
#define PG8_LDA(dst, b, h) do { _Pragma("unroll") for (int m = 0; m < 4; ++m) _Pragma("unroll") for (int k = 0; k < 2; ++k) dst[m][k] = *(const PG8_LAS bf16x8*)(lds + PG8_SA(b, h) + aoff + m * 2048 + k * 1024); } while (0)
#define PG8_LDB(dst, b, h) do { _Pragma("unroll") for (int n = 0; n < 2; ++n) _Pragma("unroll") for (int k = 0; k < 2; ++k) dst[n][k] = *(const PG8_LAS bf16x8*)(lds + PG8_SB(b, h) + boff + n * 2048 + k * 1024); } while (0)
#define PG8_MMA(ai, bj, At, Bt) do { __builtin_amdgcn_s_setprio(1); _Pragma("unroll") for (int m = 0; m < 4; ++m) _Pragma("unroll") for (int n = 0; n < 2; ++n) _Pragma("unroll") for (int k = 0; k < 2; ++k) \
        acc[ai][bj][m][n] = __builtin_amdgcn_mfma_f32_16x16x32_bf16(Bt[n][k], At[m][k], acc[ai][bj][m][n], 0, 0, 0); __builtin_amdgcn_s_setprio(0); } while (0)
#define PG8_WAIT_V(n) asm volatile("s_waitcnt vmcnt(" #n ")" ::: "memory")
#define PG8_WAIT_L(n) asm volatile("s_waitcnt lgkmcnt(" #n ")" ::: "memory")
#define PG8_BAR __builtin_amdgcn_s_barrier()
#define PG8_SCHED __builtin_amdgcn_sched_barrier(0)
    Unit cur, nxt; int ui = 0;
    if (!S.next(0, cur)) return;
    f32x4 acc[2][2][4][2];
#pragma unroll
    for (int a = 0; a < 2; ++a)
#pragma unroll
        for (int b = 0; b < 2; ++b)
#pragma unroll
            for (int m = 0; m < 4; ++m)
#pragma unroll
                for (int n = 0; n < 2; ++n) acc[a][b][m][n] = (f32x4){0.f, 0.f, 0.f, 0.f};
    bf16x8 At[4][2], B0[2][2], B1[2][2];
    const char* cA = (const char*)g.A + (size_t)cur.pm * tstep; const char* cB = (const char*)g.Bt + (size_t)cur.pn * tstep;
    S.a_ready(cur);
    if constexpr (SP2) {
        PG8_STAGE(PG8_SB(0, 0), cB, voffB); PG8_STAGE(PG8_SB(0, 1), cB + hstep, voffB); PG8_STAGE(PG8_SA(0, 0), cA, voffA); PG8_STAGE(PG8_SA(0, 1), cA + hstep, voffA);
        if (wr == 1) PG8_BAR;
        PG8_WAIT_V(2); PG8_BAR;
        PG8_STAGE(PG8_SB(1, 0), cB + kstep, voffB); PG8_STAGE(PG8_SA(1, 0), cA + kstep, voffA); PG8_STAGE(PG8_SB(1, 1), cB + hstep + kstep, voffB);
        PG8_WAIT_V(6); PG8_BAR;
    } else {
        PG8_STAGE(PG8_SB(0, 0), cB, voffB); PG8_STAGE(PG8_SA(0, 0), cA, voffA); PG8_STAGE(PG8_SB(0, 1), cB + hstep, voffB); PG8_STAGE(PG8_SA(0, 1), cA + hstep, voffA);
        if (wr == 1) PG8_BAR;
        PG8_WAIT_V(4); PG8_BAR;
        PG8_STAGE(PG8_SB(1, 0), cB + kstep, voffB); PG8_STAGE(PG8_SA(1, 0), cA + kstep, voffA); PG8_STAGE(PG8_SB(1, 1), cB + hstep + kstep, voffB);
        PG8_WAIT_V(6); PG8_BAR;
    }
    for (;;) {
        const bool has_next = S.next(ui + 1, nxt);
        const char* nA = has_next ? (const char*)g.A + (size_t)nxt.pm * tstep : cA; const char* nB = has_next ? (const char*)g.Bt + (size_t)nxt.pn * tstep : cB;
        for (int t = 0; t < nt; t += 2) {
            const bool last = (t == nt - 2);
            const char* a1 = cA + (size_t)(t + 1) * kstep;
            const char* a2 = last ? nA : cA + (size_t)(t + 2) * kstep; const char* b2 = last ? nB : cB + (size_t)(t + 2) * kstep;
            const char* a3 = a2 + kstep; const char* b3 = b2 + kstep;
            if (last && has_next) S.a_ready(nxt);
            if constexpr (SP2) {
            PG8_LDB(B0, 0, 0); PG8_LDB(B1, 0, 1); PG8_SCHED; PG8_LDA(At, 0, 0); PG8_STAGE(PG8_SA(1, 1), a1 + hstep, voffA);
            PG8_WAIT_V(8); PG8_WAIT_L(0); PG8_BAR; PG8_MMA(0, 0, At, B0); PG8_MMA(0, 1, At, B1); PG8_BAR; PG8_SCHED;
            PG8_LDA(At, 0, 1); PG8_STAGE(PG8_SB(0, 0), b2, voffB); PG8_STAGE(PG8_SB(0, 1), b2 + hstep, voffB); PG8_STAGE(PG8_SA(0, 0), a2, voffA);
            PG8_WAIT_V(8); PG8_WAIT_L(0); PG8_BAR; PG8_MMA(1, 0, At, B0); PG8_MMA(1, 1, At, B1); PG8_BAR; PG8_SCHED;
            PG8_LDB(B0, 1, 0); PG8_LDB(B1, 1, 1); PG8_SCHED; PG8_LDA(At, 1, 0); PG8_STAGE(PG8_SA(0, 1), a2 + hstep, voffA);
            PG8_WAIT_V(8); PG8_WAIT_L(0); PG8_BAR; PG8_MMA(0, 0, At, B0); PG8_MMA(0, 1, At, B1); PG8_BAR; PG8_SCHED;
            PG8_LDA(At, 1, 1); PG8_STAGE(PG8_SB(1, 0), b3, voffB); PG8_STAGE(PG8_SB(1, 1), b3 + hstep, voffB); PG8_STAGE(PG8_SA(1, 0), a3, voffA);
            PG8_WAIT_V(8); PG8_WAIT_L(0); PG8_BAR; PG8_MMA(1, 0, At, B0); PG8_MMA(1, 1, At, B1); PG8_BAR; PG8_SCHED;
            } else {
            PG8_LDB(B0, 0, 0); PG8_SCHED; PG8_LDA(At, 0, 0); PG8_STAGE(PG8_SA(1, 1), a1 + hstep, voffA);
            PG8_WAIT_L(8); PG8_BAR; PG8_WAIT_L(0); PG8_MMA(0, 0, At, B0); PG8_BAR; PG8_SCHED;
            PG8_LDB(B1, 0, 1); PG8_STAGE(PG8_SB(0, 0), b2, voffB);
            PG8_BAR; PG8_WAIT_L(0); PG8_MMA(0, 1, At, B1); PG8_BAR;
            PG8_LDA(At, 0, 1); PG8_STAGE(PG8_SA(0, 0), a2, voffA);
            PG8_BAR; PG8_WAIT_L(0); PG8_MMA(1, 0, At, B0); PG8_BAR; PG8_SCHED;
            PG8_STAGE(PG8_SB(0, 1), b2 + hstep, voffB);
            PG8_WAIT_V(6); PG8_BAR; PG8_MMA(1, 1, At, B1); PG8_BAR;
            PG8_LDB(B0, 1, 0); PG8_SCHED; PG8_LDA(At, 1, 0); PG8_STAGE(PG8_SA(0, 1), a2 + hstep, voffA);
            PG8_WAIT_L(8); PG8_BAR; PG8_WAIT_L(0); PG8_MMA(0, 0, At, B0); PG8_BAR; PG8_SCHED;
            PG8_LDB(B1, 1, 1); PG8_STAGE(PG8_SB(1, 0), b3, voffB);
            PG8_BAR; PG8_WAIT_L(0); PG8_MMA(0, 1, At, B1); PG8_BAR;
            PG8_LDA(At, 1, 1); PG8_STAGE(PG8_SA(1, 0), a3, voffA);
            PG8_BAR; PG8_WAIT_L(0); PG8_MMA(1, 0, At, B0); PG8_BAR; PG8_SCHED;
            PG8_STAGE(PG8_SB(1, 1), b3 + hstep, voffB);
            PG8_WAIT_V(6); PG8_BAR; PG8_MMA(1, 1, At, B1); PG8_BAR;
            }
        }
        if constexpr (ALIGN_EPI) { if (wr == 0) PG8_BAR; }
        if constexpr (!Epi::AFTER_DRAIN) { E(acc, cur, wr, wc, fr, fq); S.done(cur); }
        if (!has_next) break;
#pragma unroll
        for (int a = 0; a < 2; ++a)
#pragma unroll
            for (int b = 0; b < 2; ++b)
#pragma unroll
                for (int m = 0; m < 4; ++m)
#pragma unroll
                    for (int n = 0; n < 2; ++n) acc[a][b][m][n] = (f32x4){0.f, 0.f, 0.f, 0.f};
        cur = nxt; cA = nA; cB = nB; ++ui;
        if constexpr (ALIGN_EPI) { if (wr == 1) PG8_BAR; }
    }
    PG8_WAIT_V(0);
    if constexpr (!ALIGN_EPI) { if (wr == 0) PG8_BAR; }
    PG8_BAR;
    if constexpr (Epi::AFTER_DRAIN) { E.fused(acc, cur, wr, wc, fr, fq, lds, wid, lane); S.done(cur); }
#undef PG8_SA
#undef PG8_SB
#undef PG8_STAGE
#undef PG8_LDA
#undef PG8_LDB
#undef PG8_MMA
#undef PG8_WAIT_V
#undef PG8_WAIT_L
#undef PG8_BAR
#undef PG8_SCHED
}
}

#define LAS __attribute__((address_space(3)))
typedef unsigned short bf16_t;
typedef short bf16x8 __attribute__((ext_vector_type(8)));
typedef short s16x4 __attribute__((ext_vector_type(4)));
typedef float f32x4 __attribute__((ext_vector_type(4)));
typedef float f32x16 __attribute__((ext_vector_type(16)));
typedef unsigned u32x4 __attribute__((ext_vector_type(4)));
typedef unsigned u32x2 __attribute__((ext_vector_type(2)));

#ifndef PP_BALANCED
#define PP_BALANCED 0
#endif
#ifndef EXTRA_SYNCS
#define EXTRA_SYNCS 0
#endif
#ifndef PROBE_SEL
#define PROBE_SEL 0
#endif
#ifndef REPEAT_MASK
#define REPEAT_MASK 0u
#endif
#ifndef NPH_LIMIT
#define NPH_LIMIT 25
#endif

constexpr int DM = 1024, MP = 4 * 4096, MS = 8 * 8192, MT = MP + MS;
constexpr int SP = 4096, SS = 8192;
constexpr int NMR = 12 * 256;
constexpr float EPS = 1e-6f, LOG2E = 1.4426950408889634f;
constexpr float LAMBDA_INIT = 0.35550906759f;

constexpr size_t MiB = 1u << 20;
constexpr size_t O_COS = 1 * MiB, O_SIN = 2 * MiB;
constexpr size_t O_W_MLA_IN = 3 * MiB;
constexpr size_t O_W_MLA_UQ = O_W_MLA_IN + 2 * MiB;
constexpr size_t O_W_MLA_UKV = O_W_MLA_UQ + 1 * MiB;
constexpr size_t O_W_MLA_O = O_W_MLA_UKV + 1 * MiB;
constexpr size_t O_W_DIFF_IN = O_W_MLA_O + 2 * MiB;
constexpr size_t O_W_DIFF_O = O_W_DIFF_IN + 6 * MiB;
constexpr size_t O_W_XQ = O_W_DIFF_O + 2 * MiB;
constexpr size_t O_W_XKV = O_W_XQ + 4 * MiB;
constexpr size_t O_W_XO = O_W_XKV + 8 * MiB;
constexpr size_t O_W_1 = O_W_XO + 4 * MiB;
constexpr size_t O_W_2 = O_W_1 + 16 * MiB;
constexpr size_t O_MEMN = O_W_2 + 16 * MiB;
constexpr size_t O_MKV = O_MEMN + 12 * MiB;
constexpr size_t A0 = 104 * MiB;
static_assert(O_MKV + 24 * MiB <= A0, "fixed region");
constexpr size_t O_XH = A0;
constexpr size_t O_VH = A0;
constexpr size_t O_O = A0 + 160 * MiB;
constexpr size_t O_C = O_O, O_CNQ = O_O + 120 * MiB;
constexpr size_t O_ACT = A0 + 160 * MiB;
constexpr size_t O_BR = A0 + 320 * MiB;
constexpr size_t O_Q = O_BR, O_KH = O_BR + 240 * MiB, O_CNKV = O_BR + 480 * MiB, O_XQ = O_BR;
constexpr size_t O_DQ = O_BR, O_DKH = O_BR + 160 * MiB, O_DVH = O_BR + 320 * MiB;
constexpr size_t WS_END = A0 + 880 * MiB;
static_assert(WS_END <= 1024 * MiB, "workspace");

constexpr int LDS_BYTES = 163840;

struct Params { const float* in[22]; float* out; unsigned char* ws; };

__device__ __forceinline__ unsigned cvtpk(float lo, float hi) { unsigned r; asm volatile("v_cvt_pk_bf16_f32 %0, %1, %2" : "=v"(r) : "v"(lo), "v"(hi)); return r; }
__device__ __forceinline__ int otid() { int t = threadIdx.x; asm volatile("" : "+v"(t)); return t; }
__device__ __forceinline__ bf16x8 scale_frag(bf16x8 x, float c) {
    float f[8];
#pragma unroll
    for (int e = 0; e < 8; ++e) f[e] = __uint_as_float(((unsigned)(unsigned short)x[e]) << 16) * c;
    u32x4 w = {cvtpk(f[0], f[1]), cvtpk(f[2], f[3]), cvtpk(f[4], f[5]), cvtpk(f[6], f[7])};
    return __builtin_bit_cast(bf16x8, w);
}
__device__ __forceinline__ float bflo(unsigned w) { return __uint_as_float(w << 16); }
__device__ __forceinline__ float bfhi(unsigned w) { return __uint_as_float(w & 0xffff0000u); }
__device__ __forceinline__ float bf1(short s) { return __uint_as_float(((unsigned)(unsigned short)s) << 16); }
template <int CTRL> __device__ __forceinline__ float dppx(float v) { return __int_as_float(__builtin_amdgcn_update_dpp(0, __float_as_int(v), CTRL, 0xF, 0xF, true)); }
__device__ __forceinline__ float half_sum(float v) {
    v += dppx<0xB1>(v); v += dppx<0x4E>(v); v += dppx<0x141>(v); v += dppx<0x140>(v);
    v += __int_as_float(__builtin_amdgcn_ds_swizzle(__float_as_int(v), 0x401F));
    return v;
}
__device__ __forceinline__ float wave_sum(float v) {
    v = half_sum(v);
    auto rr = __builtin_amdgcn_permlane32_swap(__float_as_uint(v), __float_as_uint(v), false, false);
    return __uint_as_float(rr[0]) + __uint_as_float(rr[1]);
}
__device__ __forceinline__ int tok_pos(int row) { return row < MP ? (row & (SP - 1)) : ((row - MP) & (SS - 1)); }

__device__ __forceinline__ void transpose_item(const float* __restrict__ W, int K, int N, bf16_t* __restrict__ WT, LAS float* scr, int item, int lane) {
    const int nblk = N / 32, kb = item / nblk, nb = item % nblk, k0 = 64 * kb, n0 = 32 * nb;
#pragma unroll 8
    for (int i = 0; i < 32; ++i) { const int kk = 2 * i + (lane >> 5); scr[kk * 33 + (lane & 31)] = W[(size_t)(k0 + kk) * N + n0 + (lane & 31)]; }
    asm volatile("s_waitcnt lgkmcnt(0)" ::: "memory");
    const int c = lane & 7;
#pragma unroll
    for (int j = 0; j < 4; ++j) { const int n = (lane >> 3) + 8 * j; const LAS float* s = scr + (8 * c) * 33 + n;
        u32x4 o; o.x = cvtpk(s[0 * 33], s[1 * 33]); o.y = cvtpk(s[2 * 33], s[3 * 33]); o.z = cvtpk(s[4 * 33], s[5 * 33]); o.w = cvtpk(s[6 * 33], s[7 * 33]);
        *(u32x4*)(WT + (size_t)(n0 + n) * K + k0 + 8 * c) = o; }
    asm volatile("s_waitcnt lgkmcnt(0)" ::: "memory");
}

__device__ __forceinline__ void norm_store_row(const f32x4 (&v)[4], const float* __restrict__ g, bf16_t* __restrict__ orow, int lane) {
    float s = 0.f;
#pragma unroll
    for (int j = 0; j < 4; ++j) s += (v[j].x * v[j].x + v[j].y * v[j].y) + (v[j].z * v[j].z + v[j].w * v[j].w);
    s = wave_sum(s);
    const float rs = 1.0f / sqrtf(s * (1.f / 1024.f) + EPS);
#pragma unroll
    for (int j = 0; j < 4; ++j) { const f32x4 gg = *(const f32x4*)(g + 4 * lane + 256 * j);
        u32x2 w; w.x = cvtpk(v[j].x * rs * gg.x, v[j].y * rs * gg.y); w.y = cvtpk(v[j].z * rs * gg.z, v[j].w * rs * gg.w);
        *(u32x2*)(orow + 4 * lane + 256 * j) = w; }
}

__device__ __forceinline__ void phase_prologue(const Params& P, LAS unsigned char* lds, int vcu, int NGW) {
    const int tid = otid(), lane = tid & 63, wave = __builtin_amdgcn_readfirstlane(tid >> 6), gw = vcu * 8 + wave;
    unsigned char* ws = P.ws;
    LAS float* scr = (LAS float*)(lds + wave * 16384);
    {
        constexpr int I0 = (1024 / 64) * (576 / 32), I1 = (256 / 64) * (1536 / 32), I2 = (256 / 64) * (2048 / 32), I3 = (1024 / 64) * (1024 / 32),
                      I4 = (1024 / 64) * (3072 / 32), I5 = I3, I6 = I3, I7 = (1024 / 64) * (2048 / 32), I8 = I3, I9 = (1024 / 64) * (4096 / 32), I10 = (4096 / 64) * (1024 / 32);
        constexpr int NIT = I0 + I1 + I2 + I3 + I4 + I5 + 2 * I6 + 2 * I7 + 2 * I8 + 2 * I9 + 2 * I10;
        for (int it = gw; it < NIT; it += NGW) {
            int r = it;
#define TJ(CNT, SRC, KK, NN, DST) if (r < (CNT)) { transpose_item((SRC), (KK), (NN), (bf16_t*)(ws + (DST)), scr, r, lane); continue; } r -= (CNT);
            TJ(I0, P.in[6], 1024, 576, O_W_MLA_IN)
            TJ(I1, P.in[9], 256, 1536, O_W_MLA_UQ)
            TJ(I2, P.in[10], 256, 2048, O_W_MLA_UKV)
            TJ(I3, P.in[11], 1024, 1024, O_W_MLA_O)
            TJ(I4, P.in[12], 1024, 3072, O_W_DIFF_IN)
            TJ(I5, P.in[15], 1024, 1024, O_W_DIFF_O)
            TJ(I6, P.in[17], 1024, 1024, O_W_XQ)
            TJ(I6, P.in[17] + 1024 * 1024, 1024, 1024, O_W_XQ + 2 * MiB)
            TJ(I7, P.in[18], 1024, 2048, O_W_XKV)
            TJ(I7, P.in[18] + 1024 * 2048, 1024, 2048, O_W_XKV + 4 * MiB)
            TJ(I8, P.in[19], 1024, 1024, O_W_XO)
            TJ(I8, P.in[19] + 1024 * 1024, 1024, 1024, O_W_XO + 2 * MiB)
            TJ(I9, P.in[20], 1024, 4096, O_W_1)
            TJ(I9, P.in[20] + 1024 * 4096, 1024, 4096, O_W_1 + 8 * MiB)
            TJ(I10, P.in[21], 4096, 1024, O_W_2)
            TJ(I10, P.in[21] + 4096 * 1024, 4096, 1024, O_W_2 + 8 * MiB)
#undef TJ
        }
    }
    {
        float* cosT = (float*)(ws + O_COS); float* sinT = (float*)(ws + O_SIN);
        for (int idx = gw * 64 + lane; idx < 8192 * 32; idx += NGW * 64) {
            const int pos = idx >> 5, i = idx & 31;
            const float fr = exp2f(-(float)i * (13.287712379549449f / 32.f));
            const float ang = (float)pos * fr;
            cosT[idx] = cosf(ang); sinT[idx] = sinf(ang);
        }
    }
    for (int r = gw; r < 2 * NMR; r += NGW) {
        const int li = r / NMR, rr = r % NMR;
        const float* src = rr < 1024 ? P.in[2] + (size_t)rr * DM : P.in[3] + (size_t)(rr - 1024) * DM;
        f32x4 v[4];
#pragma unroll
        for (int j = 0; j < 4; ++j) v[j] = *(const f32x4*)(src + 4 * lane + 256 * j);
        norm_store_row(v, P.in[16] + li * DM, (bf16_t*)(ws + O_MEMN) + (size_t)r * DM, lane);
    }
    for (int r = gw; r < MT; r += NGW) {
        const float* src = r < MP ? P.in[0] + (size_t)r * DM : P.in[1] + (size_t)(r - MP) * DM;
        f32x4 v[4];
#pragma unroll
        for (int j = 0; j < 4; ++j) v[j] = *(const f32x4*)(src + 4 * lane + 256 * j);
        norm_store_row(v, P.in[4], (bf16_t*)(ws + O_XH) + (size_t)r * DM, lane);
    }
}

__device__ __forceinline__ void phase_resnorm(const Params& P, const float* __restrict__ ga, const float* __restrict__ gb, int vcu, int NGW, bool first) {
#define XSRC(row) ((first) ? ((row) < MP ? P.in[0] + (size_t)(row) * DM : P.in[1] + (size_t)((row) - MP) * DM) : (const float*)(P.out + (size_t)(row) * DM))
    const int tid = otid(), lane = tid & 63, gw = vcu * 8 + __builtin_amdgcn_readfirstlane(tid >> 6);
    bf16_t* H = (bf16_t*)(P.ws + O_XH);
    int r = gw;
    for (; r + NGW < MT; r += 2 * NGW) {
        f32x4 h0[4], x0[4], h1[4], x1[4]; float s0 = 0.f, s1 = 0.f;
        const size_t o0 = (size_t)r * DM + 4 * lane, o1 = (size_t)(r + NGW) * DM + 4 * lane;
#pragma unroll
        for (int j = 0; j < 4; ++j) { const u32x2 w0 = *(const u32x2*)(H + o0 + 256 * j), w1 = *(const u32x2*)(H + o1 + 256 * j);
            h0[j] = (f32x4){bflo(w0.x), bfhi(w0.x), bflo(w0.y), bfhi(w0.y)}; h1[j] = (f32x4){bflo(w1.x), bfhi(w1.x), bflo(w1.y), bfhi(w1.y)};
            x0[j] = __builtin_nontemporal_load((const f32x4*)(XSRC(r) + 4 * lane + 256 * j)); x1[j] = __builtin_nontemporal_load((const f32x4*)(XSRC(r + NGW) + 4 * lane + 256 * j));
            s0 += (h0[j].x * h0[j].x + h0[j].y * h0[j].y) + (h0[j].z * h0[j].z + h0[j].w * h0[j].w);
            s1 += (h1[j].x * h1[j].x + h1[j].y * h1[j].y) + (h1[j].z * h1[j].z + h1[j].w * h1[j].w); }
        s0 = wave_sum(s0); s1 = wave_sum(s1);
        const float rs0 = 1.0f / sqrtf(s0 * (1.f / 1024.f) + EPS), rs1 = 1.0f / sqrtf(s1 * (1.f / 1024.f) + EPS);
#pragma unroll
        for (int j = 0; j < 4; ++j) { const f32x4 gg = *(const f32x4*)(ga + 4 * lane + 256 * j);
            x0[j] = x0[j] + h0[j] * rs0 * gg; x1[j] = x1[j] + h1[j] * rs1 * gg;
            __builtin_nontemporal_store(x0[j], (f32x4*)(P.out + o0 + 256 * j)); __builtin_nontemporal_store(x1[j], (f32x4*)(P.out + o1 + 256 * j)); }
        if (gb) { norm_store_row(x0, gb, H + (size_t)r * DM, lane); norm_store_row(x1, gb, H + (size_t)(r + NGW) * DM, lane); }
    }
    for (; r < MT; r += NGW) {
        f32x4 h[4], x[4]; float s = 0.f;
#pragma unroll
        for (int j = 0; j < 4; ++j) { const u32x2 w = *(const u32x2*)(H + (size_t)r * DM + 4 * lane + 256 * j);
            h[j] = (f32x4){bflo(w.x), bfhi(w.x), bflo(w.y), bfhi(w.y)};
            x[j] = *(const f32x4*)(XSRC(r) + 4 * lane + 256 * j);
            s += (h[j].x * h[j].x + h[j].y * h[j].y) + (h[j].z * h[j].z + h[j].w * h[j].w); }
        s = wave_sum(s);
        const float rs = 1.0f / sqrtf(s * (1.f / 1024.f) + EPS);
#pragma unroll
        for (int j = 0; j < 4; ++j) { const f32x4 gg = *(const f32x4*)(ga + 4 * lane + 256 * j);
            x[j] = x[j] + h[j] * rs * gg;
            *(f32x4*)(P.out + (size_t)r * DM + 4 * lane + 256 * j) = x[j]; }
        if (gb) norm_store_row(x, gb, H + (size_t)r * DM, lane);
    }
}

#undef XSRC
__device__ __forceinline__ void phase_cnorm(const Params& P, int vcu, int NGW) {
    const int tid = otid(), lane = tid & 63, gw = vcu * 8 + __builtin_amdgcn_readfirstlane(tid >> 6);
    const bf16_t* C = (const bf16_t*)(P.ws + O_C);
    bf16_t* CNQ = (bf16_t*)(P.ws + O_CNQ); bf16_t* CNKV = (bf16_t*)(P.ws + O_CNKV); bf16_t* KH = (bf16_t*)(P.ws + O_KH);
    const float* cosT = (const float*)(P.ws + O_COS); const float* sinT = (const float*)(P.ws + O_SIN);
    const f32x4 gq = *(const f32x4*)(P.in[7] + 4 * lane), gk = *(const f32x4*)(P.in[8] + 4 * lane);
    for (int r = gw; r < MT; r += NGW) {
        const bf16_t* c = C + (size_t)r * 768;
        const u32x2 a = *(const u32x2*)(c + 4 * lane), b = *(const u32x2*)(c + 256 + 4 * lane);
        const float kr = __uint_as_float(((unsigned)c[512 + lane]) << 16);
        const f32x4 va = {bflo(a.x), bfhi(a.x), bflo(a.y), bfhi(a.y)}, vb = {bflo(b.x), bfhi(b.x), bflo(b.y), bfhi(b.y)};
        float sa = (va.x * va.x + va.y * va.y) + (va.z * va.z + va.w * va.w), sb = (vb.x * vb.x + vb.y * vb.y) + (vb.z * vb.z + vb.w * vb.w);
        sa = wave_sum(sa); sb = wave_sum(sb);
        const float ra = 1.0f / sqrtf(sa * (1.f / 256.f) + EPS), rb = 1.0f / sqrtf(sb * (1.f / 256.f) + EPS);
        u32x2 wa, wb;
        wa.x = cvtpk(va.x * ra * gq.x, va.y * ra * gq.y); wa.y = cvtpk(va.z * ra * gq.z, va.w * ra * gq.w);
        wb.x = cvtpk(vb.x * rb * gk.x, vb.y * rb * gk.y); wb.y = cvtpk(vb.z * rb * gk.z, vb.w * rb * gk.w);
        *(u32x2*)(CNQ + (size_t)r * 256 + 4 * lane) = wa;
        *(u32x2*)(CNKV + (size_t)r * 256 + 4 * lane) = wb;
        const int pos = tok_pos(r), i = lane & 31;
        const float cs = cosT[pos * 32 + i], sn = sinT[pos * 32 + i];
        float pr; { auto rr = __builtin_amdgcn_permlane32_swap(__float_as_uint(kr), __float_as_uint(kr), false, false); pr = __uint_as_float(lane < 32 ? rr[1] : rr[0]); }
        const float o = lane < 32 ? kr * cs - pr * sn : pr * sn + kr * cs;
        const bf16_t ob = (bf16_t)(cvtpk(o, 0.f) & 0xffffu);
#pragma unroll
        for (int h = 0; h < 8; ++h) KH[((size_t)h * MT + r) * 192 + 128 + lane] = ob;
    }
}

namespace att {
constexpr int LDS_V = 0, LDS_K = 16384, LDS_WS = 49152, LDS_TAB = 51200, LDS_STASH = 53248;
__device__ __forceinline__ int crow(int r, int hi) { return (r & 3) + 8 * (r >> 2) + 4 * hi; }
#define SBAR() __builtin_amdgcn_sched_barrier(0)
__device__ __forceinline__ int v_st(int k, int c) { const int kk = (k & ~0xC) | ((k & 4) << 1) | ((k & 8) >> 1); return ((kk >> 3) * 4 + (c >> 5)) * 512 + ((kk & 7) * 32 + (c & 31)) * 2; }
__device__ __forceinline__ int v_rd_base(int lane) { return ((lane & 3) << 3) | (((lane >> 2) & 3) << 6) | (((lane >> 4) & 1) << 5) | (((lane >> 5) & 1) << 8); }
constexpr int v_rd_off(int d0, int ks, int half) { return d0 * 512 + ks * 4096 + half * 2048; }
template <int OFF> __device__ __forceinline__ s16x4 tr_read(int vb) {
    s16x4 r; asm volatile("ds_read_b64_tr_b16 %0, %1 offset:%2" : "=&v"(r) : "v"(vb), "i"(OFF) : "memory"); return r;
}
template <int D0> __device__ __forceinline__ void pv_one(f32x16& od, int vb, bf16x8 pa0, bf16x8 pa1, bf16x8 pa2, bf16x8 pa3) {
    const s16x4 l0 = tr_read<v_rd_off(D0, 0, 0)>(vb), h0 = tr_read<v_rd_off(D0, 0, 1)>(vb), l1 = tr_read<v_rd_off(D0, 1, 0)>(vb), h1 = tr_read<v_rd_off(D0, 1, 1)>(vb);
    const s16x4 l2 = tr_read<v_rd_off(D0, 2, 0)>(vb), h2 = tr_read<v_rd_off(D0, 2, 1)>(vb), l3 = tr_read<v_rd_off(D0, 3, 0)>(vb), h3 = tr_read<v_rd_off(D0, 3, 1)>(vb);
    asm volatile("s_waitcnt lgkmcnt(0)" ::: "memory"); SBAR();
#define PK(L, H) (bf16x8){L[0], L[1], L[2], L[3], H[0], H[1], H[2], H[3]}
    od = __builtin_amdgcn_mfma_f32_32x32x16_bf16(pa0, PK(l0, h0), od, 0, 0, 0);
    od = __builtin_amdgcn_mfma_f32_32x32x16_bf16(pa1, PK(l1, h1), od, 0, 0, 0);
    od = __builtin_amdgcn_mfma_f32_32x32x16_bf16(pa2, PK(l2, h2), od, 0, 0, 0);
    od = __builtin_amdgcn_mfma_f32_32x32x16_bf16(pa3, PK(l3, h3), od, 0, 0, 0);
#undef PK
}

template <int D0> __device__ __forceinline__ void pv_rd(s16x4 (&l)[4], s16x4 (&h)[4], int vb) {
    l[0] = tr_read<v_rd_off(D0, 0, 0)>(vb); h[0] = tr_read<v_rd_off(D0, 0, 1)>(vb); l[1] = tr_read<v_rd_off(D0, 1, 0)>(vb); h[1] = tr_read<v_rd_off(D0, 1, 1)>(vb);
    l[2] = tr_read<v_rd_off(D0, 2, 0)>(vb); h[2] = tr_read<v_rd_off(D0, 2, 1)>(vb); l[3] = tr_read<v_rd_off(D0, 3, 0)>(vb); h[3] = tr_read<v_rd_off(D0, 3, 1)>(vb);
}
__device__ __forceinline__ void pv_mm(f32x16& od, const s16x4 (&l)[4], const s16x4 (&h)[4], bf16x8 pa0, bf16x8 pa1, bf16x8 pa2, bf16x8 pa3) {
#define PK(L, H) (bf16x8){L[0], L[1], L[2], L[3], H[0], H[1], H[2], H[3]}
    od = __builtin_amdgcn_mfma_f32_32x32x16_bf16(pa0, PK(l[0], h[0]), od, 0, 0, 0);
    od = __builtin_amdgcn_mfma_f32_32x32x16_bf16(pa1, PK(l[1], h[1]), od, 0, 0, 0);
    od = __builtin_amdgcn_mfma_f32_32x32x16_bf16(pa2, PK(l[2], h[2]), od, 0, 0, 0);
    od = __builtin_amdgcn_mfma_f32_32x32x16_bf16(pa3, PK(l[3], h[3]), od, 0, 0, 0);
#undef PK
}
template <int B0> __device__ __forceinline__ void pv_half(f32x16 (&o)[4], int vb, bf16x8 pa0, bf16x8 pa1, bf16x8 pa2, bf16x8 pa3) {
    s16x4 la[4], ha[4], lb[4], hb[4];
    asm volatile("s_waitcnt lgkmcnt(0)" ::: "memory");
    pv_rd<B0>(la, ha, vb); pv_rd<B0 + 1>(lb, hb, vb);
    asm volatile("s_waitcnt lgkmcnt(8)" ::: "memory"); SBAR(); pv_mm(o[B0], la, ha, pa0, pa1, pa2, pa3); SBAR();
    asm volatile("s_waitcnt lgkmcnt(0)" ::: "memory"); SBAR(); pv_mm(o[B0 + 1], lb, hb, pa0, pa1, pa2, pa3); SBAR();
}
__device__ __forceinline__ void pv_all(f32x16 (&o)[4], int vb, bf16x8 pa0, bf16x8 pa1, bf16x8 pa2, bf16x8 pa3) {
    s16x4 la[4], ha[4], lb[4], hb[4];
    asm volatile("s_waitcnt lgkmcnt(0)" ::: "memory");
    pv_rd<0>(la, ha, vb); pv_rd<1>(lb, hb, vb);
    asm volatile("s_waitcnt lgkmcnt(8)" ::: "memory"); SBAR(); pv_mm(o[0], la, ha, pa0, pa1, pa2, pa3); SBAR();
    pv_rd<2>(la, ha, vb);
    asm volatile("s_waitcnt lgkmcnt(8)" ::: "memory"); SBAR(); pv_mm(o[1], lb, hb, pa0, pa1, pa2, pa3); SBAR();
    pv_rd<3>(lb, hb, vb);
    asm volatile("s_waitcnt lgkmcnt(8)" ::: "memory"); SBAR(); pv_mm(o[2], la, ha, pa0, pa1, pa2, pa3); SBAR();
    asm volatile("s_waitcnt lgkmcnt(0)" ::: "memory"); SBAR(); pv_mm(o[3], lb, hb, pa0, pa1, pa2, pa3); SBAR();
}

template <int DQK, bool MLAK, bool BIAS, bool PREFETCH>
__device__ __forceinline__ void attn_core(f32x16 (&o)[4], const bf16x8 (&qr)[DQK / 16],
                                          const bf16_t* __restrict__ Kg, int ldk, const bf16_t* __restrict__ K2g, const bf16_t* __restrict__ Vg, int ldv,
                                          int nkeys, float C, int qw0, LAS char* lds) {
    constexpr int PITCH = DQK * 2, CPR = DQK / 8, NKCH = DQK / 64;
    const int tid = otid(), wid = tid >> 6, lane = tid & 63, r32 = lane & 31, hi = lane >> 5;
    LAS char* V_lds = lds + LDS_V; LAS char* K_lds = lds + LDS_K;
    LAS float* wsf = (LAS float*)(lds + LDS_WS) + wid * 64; LAS float* li_l = wsf; LAS float* al_l = wsf + 32;
    const LAS float* tab = (const LAS float*)(lds + LDS_TAB);
    const int sr = tid >> 4, sc = (tid & 15) * 8, vst0 = v_st(sr, sc), vst1 = v_st(32 + sr, sc);
    const unsigned voff0 = (unsigned)(sr * ldv + sc), voff1 = (unsigned)((32 + sr) * ldv + sc);
    unsigned koff[NKCH]; int kdst[NKCH];
#pragma unroll
    for (int c = 0; c < NKCH; ++c) {
        int row, col;
        if (MLAK) { if (c < 2) { row = sr + 32 * c; col = sc; } else { row = tid >> 3; col = 128 + (tid & 7) * 8; } }
        else { const int id = tid + 512 * c; row = id / CPR; col = (id % CPR) * 8; }
        koff[c] = (MLAK && c == 2) ? (unsigned)(row * 64 + (col - 128)) : (unsigned)(row * ldk + col);
        kdst[c] = row * PITCH + ((col * 2) ^ ((row & 7) << 4)); }
    const int vb0 = (int)(unsigned)(uintptr_t)V_lds + v_rd_base(lane);
    const int kro = r32 * PITCH, kx = (r32 & 7) << 4;
    float m_reg = -1e30f, l_reg = 0.f;
#pragma unroll
    for (int d = 0; d < 4; ++d) o[d] = f32x16{};
    const int NT = nkeys / 64;
    bf16x8 vs0, vs1, ks[NKCH];
#define ATT_LOAD(t) do { const bf16_t* vt_ = Vg + (size_t)(t) * 64 * ldv; const bf16_t* kt_ = Kg + (size_t)(t) * 64 * ldk; const bf16_t* k2t_ = K2g + (size_t)(t) * 64 * 64; \
        vs0 = *(const bf16x8*)(vt_ + voff0); vs1 = *(const bf16x8*)(vt_ + voff1); \
        _Pragma("unroll") for (int c = 0; c < NKCH; ++c) ks[c] = *(const bf16x8*)(((MLAK && c == 2) ? k2t_ : kt_) + koff[c]); } while (0)
    if (PREFETCH) ATT_LOAD(0);
#pragma nounroll
    for (int j = 0; j < NT; ++j) {
        __syncthreads();
        if (!PREFETCH) ATT_LOAD(j);
        *(LAS bf16x8*)(V_lds + vst0) = vs0; *(LAS bf16x8*)(V_lds + vst1) = vs1;
#pragma unroll
        for (int c = 0; c < NKCH; ++c) *(LAS bf16x8*)(K_lds + kdst[c]) = ks[c];
        __syncthreads();
        if (PREFETCH && j + 1 < NT) ATT_LOAD(j + 1);
        f32x16 p0 = f32x16{}, p1 = f32x16{};
#pragma unroll
        for (int d0 = 0; d0 < DQK / 16; ++d0) { const int cb = ((d0 * 16 + hi * 8) * 2) ^ kx;
            const bf16x8 b0 = *(const LAS bf16x8*)(K_lds + kro + cb);
            const bf16x8 b1 = *(const LAS bf16x8*)(K_lds + kro + 32 * PITCH + cb);
            p0 = __builtin_amdgcn_mfma_f32_32x32x16_bf16(b0, qr[d0], p0, 0, 0, 0);
            p1 = __builtin_amdgcn_mfma_f32_32x32x16_bf16(b1, qr[d0], p1, 0, 0, 0); }
        if constexpr (BIAS) {
            const int kq = j * 64 - qw0;
            if (kq + 63 <= -128) { const float b = tab[0];
#pragma unroll
                for (int r = 0; r < 16; ++r) { p0[r] = fmaf(p0[r], C, b); p1[r] = fmaf(p1[r], C, b); } }
            else if (kq - 31 >= 128) { const float b = tab[256];
#pragma unroll
                for (int r = 0; r < 16; ++r) { p0[r] = fmaf(p0[r], C, b); p1[r] = fmaf(p1[r], C, b); } }
            else {
#pragma unroll
                for (int r = 0; r < 16; ++r) { const int i0 = kq + crow(r, hi) - r32 + 128;
                    const int a0 = min(max(i0, 0), 256), a1 = min(max(i0 + 32, 0), 256);
                    p0[r] = fmaf(p0[r], C, tab[a0]); p1[r] = fmaf(p1[r], C, tab[a1]); } }
        } else {
#pragma unroll
            for (int r = 0; r < 16; ++r) { p0[r] *= C; p1[r] *= C; }
        }
        float pmax = p0[0];
#pragma unroll
        for (int r = 1; r < 16; ++r) pmax = fmaxf(pmax, p0[r]);
#pragma unroll
        for (int r = 0; r < 16; ++r) pmax = fmaxf(pmax, p1[r]);
        { auto rr = __builtin_amdgcn_permlane32_swap(__float_as_uint(pmax), __float_as_uint(pmax), false, false);
          pmax = fmaxf(__uint_as_float(rr[0]), __uint_as_float(rr[1])); }
        const float mn = fmaxf(m_reg, pmax);
        const float alpha = __builtin_amdgcn_exp2f(m_reg - mn); m_reg = mn;
        float ps = 0.f;
#pragma unroll
        for (int r = 0; r < 16; ++r) { p0[r] = __builtin_amdgcn_exp2f(p0[r] - mn); p1[r] = __builtin_amdgcn_exp2f(p1[r] - mn); ps += p0[r] + p1[r]; }
        { auto rr = __builtin_amdgcn_permlane32_swap(__float_as_uint(ps), __float_as_uint(ps), false, false);
          ps = __uint_as_float(rr[0]) + __uint_as_float(rr[1]); }
        l_reg = l_reg * alpha + ps;
        if (__any(alpha < 1.f)) {
            if (hi == 0) al_l[r32] = alpha;
            asm volatile("s_waitcnt lgkmcnt(0)" ::: "memory");
#pragma unroll
            for (int r = 0; r < 16; ++r) { const float a = al_l[crow(r, hi)];
#pragma unroll
                for (int d = 0; d < 4; ++d) o[d][r] *= a; }
        }
        bf16x8 pa0, pa1, pa2, pa3;
#define PK4(P, BASE, OUT) do { unsigned a0 = cvtpk(P[BASE + 0], P[BASE + 1]), a1 = cvtpk(P[BASE + 2], P[BASE + 3]);   \
    unsigned b0 = cvtpk(P[BASE + 4], P[BASE + 5]), b1 = cvtpk(P[BASE + 6], P[BASE + 7]);                              \
    auto r0 = __builtin_amdgcn_permlane32_swap(a0, b0, false, false); auto r1 = __builtin_amdgcn_permlane32_swap(a1, b1, false, false); \
    u32x4 w = {r0[0], r1[0], r0[1], r1[1]}; OUT = *reinterpret_cast<bf16x8*>(&w); } while (0)
        PK4(p0, 0, pa0); PK4(p0, 8, pa1); PK4(p1, 0, pa2); PK4(p1, 8, pa3);
#undef PK4
        SBAR();
        pv_one<0>(o[0], vb0, pa0, pa1, pa2, pa3); pv_one<1>(o[1], vb0, pa0, pa1, pa2, pa3); pv_one<2>(o[2], vb0, pa0, pa1, pa2, pa3); pv_one<3>(o[3], vb0, pa0, pa1, pa2, pa3);
    }
    if (hi == 0) li_l[r32] = l_reg;
    asm volatile("s_waitcnt lgkmcnt(0)" ::: "memory");
#pragma unroll
    for (int r = 0; r < 16; ++r) { const float rl = 1.0f / li_l[crow(r, hi)];
#pragma unroll
        for (int d = 0; d < 4; ++d) o[d][r] *= rl; }
#undef ATT_LOAD
}

template <int DQK, bool MLAK, bool BIAS>
__device__ __forceinline__ void attn_core_pp(f32x16 (&o)[4], const bf16x8 (&qr)[DQK / 16],
                                             const bf16_t* __restrict__ Kg, int ldk, const bf16_t* __restrict__ K2g, const bf16_t* __restrict__ Vg, int ldv,
                                             int nkeys, float C, int qw0, LAS char* lds, unsigned long long* prb = nullptr) {
    constexpr int PITCH = DQK * 2, KB = 64 * PITCH, CPR = DQK / 8, NKCH = DQK / 64;
    constexpr int L_V = 0, L_K = 49152, L_WS = L_K + 2 * KB, L_TAB = L_WS + 2048;
    const int tid = otid(), wid = tid >> 6, lane = tid & 63, r32 = lane & 31, hi = lane >> 5;
    const int grp = __builtin_amdgcn_readfirstlane(wid >> 2);
    LAS char* V_lds = lds + L_V; LAS char* K_lds = lds + L_K;
    LAS float* wsf = (LAS float*)(lds + L_WS) + wid * 64; LAS float* li_l = wsf; LAS float* al_l = wsf + 32;
    const LAS float* tab = (const LAS float*)(lds + L_TAB);
    const int sr = tid >> 4, sc = (tid & 15) * 8, vst0 = v_st(sr, sc), vst1 = v_st(32 + sr, sc);
    const unsigned voff0 = (unsigned)(sr * ldv + sc), voff1 = (unsigned)((32 + sr) * ldv + sc);
    unsigned koff[NKCH]; int kdst[NKCH];
#pragma unroll
    for (int c = 0; c < NKCH; ++c) {
        int row, col;
        if (MLAK) { if (c < 2) { row = sr + 32 * c; col = sc; } else { row = tid >> 3; col = 128 + (tid & 7) * 8; } }
        else { const int id = tid + 512 * c; row = id / CPR; col = (id % CPR) * 8; }
        koff[c] = (MLAK && c == 2) ? (unsigned)(row * 64 + (col - 128)) : (unsigned)(row * ldk + col);
        kdst[c] = row * PITCH + ((col * 2) ^ (((row >> 1) & 7) << 4)); }
    const int vb0 = (int)(unsigned)(uintptr_t)V_lds + v_rd_base(lane);
    const int kro = r32 * PITCH, kx = ((r32 >> 1) & 7) << 4;
    float m_reg = -1e30f, l_reg = 0.f;
#pragma unroll
    for (int d = 0; d < 4; ++d) o[d] = f32x16{};
    const int NT = nkeys / 64;
    bf16x8 vs0, vs1, ks[NKCH];
    f32x16 p0 = f32x16{}, p1 = f32x16{};
    bf16x8 pa0 = bf16x8{}, pa1 = bf16x8{}, pa2 = bf16x8{}, pa3 = bf16x8{};
#define PP_LOAD(t) do { const bf16_t* vt_ = Vg + (size_t)(t) * 64 * ldv; const bf16_t* kt_ = Kg + (size_t)(t) * 64 * ldk; const bf16_t* k2t_ = K2g + (size_t)(t) * 64 * 64; \
        vs0 = *(const bf16x8*)(vt_ + voff0); vs1 = *(const bf16x8*)(vt_ + voff1); \
        _Pragma("unroll") for (int c = 0; c < NKCH; ++c) ks[c] = *(const bf16x8*)(((MLAK && c == 2) ? k2t_ : kt_) + koff[c]); } while (0)
#define PP_WRITE(t) do { LAS char* vd_ = V_lds + ((t) % 3) * 16384; LAS char* kd_ = K_lds + ((t) & 1) * KB; \
        *(LAS bf16x8*)(vd_ + vst0) = vs0; *(LAS bf16x8*)(vd_ + vst1) = vs1; \
        _Pragma("unroll") for (int c = 0; c < NKCH; ++c) *(LAS bf16x8*)(kd_ + kdst[c]) = ks[c]; } while (0)
#define PP_KRD(dst, d0_) do { const int cb_ = (((d0_) * 16 + hi * 8) * 2) ^ kx; dst[0] = *(const LAS bf16x8*)(kb_ + cb_); dst[1] = *(const LAS bf16x8*)(kb_ + 32 * PITCH + cb_); } while (0)
#if PROBE_SEL
#define PP_QK(t) do { const LAS char* kb_ = K_lds + ((t) & 1) * KB + kro; p0 = f32x16{}; p1 = f32x16{}; \
        bf16x8 kfa[2], kfb[2]; PP_KRD(kfa, 0); \
        _Pragma("unroll") for (int d0 = 0; d0 < DQK / 16; ++d0) { \
            if (d0 + 1 < DQK / 16) { if (d0 % 2 == 0) PP_KRD(kfb, d0 + 1); else PP_KRD(kfa, d0 + 1); } \
            SBAR(); \
            if (d0 % 2 == 0) { p0 = __builtin_amdgcn_mfma_f32_32x32x16_bf16(kfa[0], qr[d0], p0, 0, 0, 0); p1 = __builtin_amdgcn_mfma_f32_32x32x16_bf16(kfa[1], qr[d0], p1, 0, 0, 0); } \
            else { p0 = __builtin_amdgcn_mfma_f32_32x32x16_bf16(kfb[0], qr[d0], p0, 0, 0, 0); p1 = __builtin_amdgcn_mfma_f32_32x32x16_bf16(kfb[1], qr[d0], p1, 0, 0, 0); } \
            SBAR(); } } while (0)
#else
#define PP_QK(t) do { const LAS char* kb_ = K_lds + ((t) & 1) * KB + kro; p0 = f32x16{}; p1 = f32x16{}; \
        bf16x8 kfa[2], kfb[2], kfc[2]; PP_KRD(kfa, 0); PP_KRD(kfb, 1); \
        _Pragma("unroll") for (int d0 = 0; d0 < DQK / 16; ++d0) { \
            if (d0 + 2 < DQK / 16) { if (d0 % 3 == 0) PP_KRD(kfc, d0 + 2); else if (d0 % 3 == 1) PP_KRD(kfa, d0 + 2); else PP_KRD(kfb, d0 + 2); } \
            SBAR(); \
            if (d0 % 3 == 0) { p0 = __builtin_amdgcn_mfma_f32_32x32x16_bf16(kfa[0], qr[d0], p0, 0, 0, 0); p1 = __builtin_amdgcn_mfma_f32_32x32x16_bf16(kfa[1], qr[d0], p1, 0, 0, 0); } \
            else if (d0 % 3 == 1) { p0 = __builtin_amdgcn_mfma_f32_32x32x16_bf16(kfb[0], qr[d0], p0, 0, 0, 0); p1 = __builtin_amdgcn_mfma_f32_32x32x16_bf16(kfb[1], qr[d0], p1, 0, 0, 0); } \
            else { p0 = __builtin_amdgcn_mfma_f32_32x32x16_bf16(kfc[0], qr[d0], p0, 0, 0, 0); p1 = __builtin_amdgcn_mfma_f32_32x32x16_bf16(kfc[1], qr[d0], p1, 0, 0, 0); } \
            SBAR(); } } while (0)
#endif
#define PK4(P, BASE, OUT) do { unsigned a0 = cvtpk(P[BASE + 0], P[BASE + 1]), a1 = cvtpk(P[BASE + 2], P[BASE + 3]);   \
    unsigned b0 = cvtpk(P[BASE + 4], P[BASE + 5]), b1 = cvtpk(P[BASE + 6], P[BASE + 7]);                              \
    auto r0 = __builtin_amdgcn_permlane32_swap(a0, b0, false, false); auto r1 = __builtin_amdgcn_permlane32_swap(a1, b1, false, false); \
    u32x4 w = {r0[0], r1[0], r0[1], r1[1]}; OUT = *reinterpret_cast<bf16x8*>(&w); } while (0)
#define PP_SMPV(t) do { \
        float pmax; \
        if constexpr (BIAS) { const int kq = (t) * 64 - qw0; \
            if (kq + 63 <= -128) { const float b = tab[0]; _Pragma("unroll") for (int r = 0; r < 16; ++r) { p0[r] = fmaf(p0[r], C, b); p1[r] = fmaf(p1[r], C, b); } } \
            else if (kq - 31 >= 128) { const float b = tab[256]; _Pragma("unroll") for (int r = 0; r < 16; ++r) { p0[r] = fmaf(p0[r], C, b); p1[r] = fmaf(p1[r], C, b); } } \
            else { _Pragma("unroll") for (int r = 0; r < 16; ++r) { const int i0 = kq + crow(r, hi) - r32 + 128; const int a0 = min(max(i0, 0), 256), a1 = min(max(i0 + 32, 0), 256); \
                    p0[r] = fmaf(p0[r], C, tab[a0]); p1[r] = fmaf(p1[r], C, tab[a1]); } } } \
        pmax = fmaxf(p0[0], p1[0]); \
        _Pragma("unroll") for (int r = 1; r < 16; ++r) pmax = fmaxf(fmaxf(pmax, p0[r]), p1[r]); \
        { auto rr = __builtin_amdgcn_permlane32_swap(__float_as_uint(pmax), __float_as_uint(pmax), false, false); pmax = fmaxf(__uint_as_float(rr[0]), __uint_as_float(rr[1])); } \
        if constexpr (!BIAS) pmax *= C; \
        const float mn = fmaxf(m_reg, pmax); const float alpha = __builtin_amdgcn_exp2f(m_reg - mn); m_reg = mn; \
        float ps = 0.f; \
        if constexpr (BIAS) { _Pragma("unroll") for (int r = 0; r < 16; ++r) { p0[r] = __builtin_amdgcn_exp2f(p0[r] - mn); p1[r] = __builtin_amdgcn_exp2f(p1[r] - mn); ps += p0[r] + p1[r]; } } \
        else { _Pragma("unroll") for (int r = 0; r < 16; ++r) { p0[r] = __builtin_amdgcn_exp2f(fmaf(p0[r], C, -mn)); p1[r] = __builtin_amdgcn_exp2f(fmaf(p1[r], C, -mn)); ps += p0[r] + p1[r]; } } \
        { auto rr = __builtin_amdgcn_permlane32_swap(__float_as_uint(ps), __float_as_uint(ps), false, false); ps = __uint_as_float(rr[0]) + __uint_as_float(rr[1]); } \
        l_reg = l_reg * alpha + ps; \
        if (__any(alpha < 1.f)) { if (hi == 0) al_l[r32] = alpha; asm volatile("s_waitcnt lgkmcnt(0)" ::: "memory"); \
            _Pragma("unroll") for (int r = 0; r < 16; ++r) { const float a = al_l[crow(r, hi)]; _Pragma("unroll") for (int d = 0; d < 4; ++d) o[d][r] *= a; } } \
        PK4(p0, 0, pa0); PK4(p0, 8, pa1); PK4(p1, 0, pa2); PK4(p1, 8, pa3); SBAR(); \
        if (PP_BALANCED) pv_half<0>(o, vb0 + ((t) % 3) * 16384, pa0, pa1, pa2, pa3); else pv_all(o, vb0 + ((t) % 3) * 16384, pa0, pa1, pa2, pa3); } while (0)
    PP_LOAD(0);
    __syncthreads();
    PP_WRITE(0);
    if (NT > 1) PP_LOAD(1);
    __syncthreads();
#define PP_BAR() do { SBAR(); asm volatile("s_waitcnt lgkmcnt(0)\n\ts_barrier" ::: "memory"); SBAR(); } while (0)
    if (grp == 1) PP_BAR();
#if PROBE_SEL
    LAS unsigned* cnt = (LAS unsigned*)(lds + L_TAB) + wid * 4;
    { unsigned z_ = 0; asm volatile("" : "+v"(z_)); if (lane < 4) cnt[lane] = z_; }
#define PT() ((unsigned)__builtin_amdgcn_readfirstlane((int)(unsigned)__builtin_readcyclecounter()))
#endif
#pragma nounroll
    for (int j = 0; j < NT; ++j) {
#if PROBE_SEL
        const unsigned t0 = PT();
#endif
        if (j + 1 < NT) { PP_WRITE(j + 1); if (j + 2 < NT) PP_LOAD(j + 2); }
        SBAR();
        if (PP_BALANCED && j > 0) pv_half<2>(o, vb0 + ((j - 1) % 3) * 16384, pa0, pa1, pa2, pa3);
        PP_QK(j);
#if PROBE_SEL
        SBAR(); const unsigned t1 = PT(); SBAR();
#endif
        PP_BAR();
#if PROBE_SEL
        SBAR(); const unsigned t2 = PT(); SBAR();
#endif
        PP_SMPV(j);
#if PROBE_SEL
        SBAR(); const unsigned t3 = PT(); SBAR();
#endif
        PP_BAR();
#if PROBE_SEL
        SBAR(); const unsigned t4 = PT(); SBAR();
        if (lane == 0) { cnt[0] += t1 - t0; cnt[1] += t2 - t1; cnt[2] += t3 - t2; cnt[3] += t4 - t3; }
#endif
    }
#if PROBE_SEL
    if (prb && lane == 0) { prb[0] += (unsigned long long)cnt[0]; prb[1] += (unsigned long long)cnt[1]; prb[2] += (unsigned long long)cnt[2]; prb[3] += (unsigned long long)cnt[3]; prb[4] += (unsigned long long)NT; }
#endif
    if (PP_BALANCED) pv_half<2>(o, vb0 + ((NT - 1) % 3) * 16384, pa0, pa1, pa2, pa3);
    if (grp == 0) PP_BAR();
#undef PP_BAR
    if (hi == 0) li_l[r32] = l_reg;
    asm volatile("s_waitcnt lgkmcnt(0)" ::: "memory");
#pragma unroll
    for (int r = 0; r < 16; ++r) { const float rl = 1.0f / li_l[crow(r, hi)];
#pragma unroll
        for (int d = 0; d < 4; ++d) o[d][r] *= rl; }
#undef PP_LOAD
#undef PP_WRITE
#undef PP_QK
#undef PP_KRD
#undef PK4
#undef PP_SMPV
}

template <int DQK, bool MLAK, bool BIAS>
__device__ __forceinline__ void attn_core_sp(f32x16 (&o)[4], const bf16x8 (&qr)[DQK / 16],
                                             const bf16_t* __restrict__ Kg, int ldk, const bf16_t* __restrict__ K2g, const bf16_t* __restrict__ Vg, int ldv,
                                             int nkeys, float C, int qw0, LAS char* lds) {
    constexpr int PITCH = DQK * 2, KBY = 64 * PITCH, CPR = DQK / 8, NKCH = DQK / 64, ND0 = DQK / 16;
    constexpr int L_V = 0, L_K = 32768, L_WS = L_K + 2 * KBY, L_TAB = L_WS + 2048;
    const int tid = otid(), wid = tid >> 6, lane = tid & 63, r32 = lane & 31, hi = lane >> 5;
    LAS char* V_lds = lds + L_V; LAS char* K_lds = lds + L_K;
    LAS float* wsf = (LAS float*)(lds + L_WS) + wid * 64; LAS float* li_l = wsf; LAS float* al_l = wsf + 32;
    const LAS float* tab = (const LAS float*)(lds + L_TAB);
    const int sr = tid >> 4, sc = (tid & 15) * 8, vst0 = v_st(sr, sc), vst1 = v_st(32 + sr, sc);
    const unsigned voff0 = (unsigned)(sr * ldv + sc), voff1 = (unsigned)((32 + sr) * ldv + sc);
    unsigned koff[NKCH]; int kdst[NKCH];
#pragma unroll
    for (int c = 0; c < NKCH; ++c) {
        int row, col;
        if (MLAK) { if (c < 2) { row = sr + 32 * c; col = sc; } else { row = tid >> 3; col = 128 + (tid & 7) * 8; } }
        else { const int id = tid + 512 * c; row = id / CPR; col = (id % CPR) * 8; }
        koff[c] = (MLAK && c == 2) ? (unsigned)(row * 64 + (col - 128)) : (unsigned)(row * ldk + col);
        kdst[c] = row * PITCH + ((col * 2) ^ (((row >> 1) & 7) << 4)); }
    const int vb0 = (int)(unsigned)(uintptr_t)V_lds + v_rd_base(lane);
    const int kro = r32 * PITCH, kx = ((r32 >> 1) & 7) << 4;
    float m_reg = -1e30f, l_reg = 0.f;
#pragma unroll
    for (int d = 0; d < 4; ++d) o[d] = f32x16{};
    const int NT = nkeys / 64;
    bf16x8 vs0, vs1, ks[NKCH];
#define SP_LOAD(t) do { const bf16_t* vt_ = Vg + (size_t)(t) * 64 * ldv; const bf16_t* kt_ = Kg + (size_t)(t) * 64 * ldk; const bf16_t* k2t_ = K2g + (size_t)(t) * 64 * 64; \
        vs0 = *(const bf16x8*)(vt_ + voff0); vs1 = *(const bf16x8*)(vt_ + voff1); \
        _Pragma("unroll") for (int c = 0; c < NKCH; ++c) ks[c] = *(const bf16x8*)(((MLAK && c == 2) ? k2t_ : kt_) + koff[c]); } while (0)
#define SP_WRITE(b) do { LAS char* vd_ = V_lds + (b) * 16384; LAS char* kd_ = K_lds + (b) * KBY; \
        *(LAS bf16x8*)(vd_ + vst0) = vs0; *(LAS bf16x8*)(vd_ + vst1) = vs1; \
        _Pragma("unroll") for (int c = 0; c < NKCH; ++c) *(LAS bf16x8*)(kd_ + kdst[c]) = ks[c]; } while (0)
#define SP_QKT(P0, P1, b) do { const LAS char* kb_ = K_lds + (b) * KBY + kro; P0 = f32x16{}; P1 = f32x16{}; \
        _Pragma("unroll") for (int d0 = 0; d0 < ND0; ++d0) { const int cb = ((d0 * 16 + hi * 8) * 2) ^ kx; \
            const bf16x8 b0 = *(const LAS bf16x8*)(kb_ + cb); const bf16x8 b1 = *(const LAS bf16x8*)(kb_ + 32 * PITCH + cb); \
            P0 = __builtin_amdgcn_mfma_f32_32x32x16_bf16(b0, qr[d0], P0, 0, 0, 0); P1 = __builtin_amdgcn_mfma_f32_32x32x16_bf16(b1, qr[d0], P1, 0, 0, 0); } } while (0)
#define SP_PART(P0, P1, ALPHA, t) do { \
        float ub = 0.f; bool uni = true;                    \
        if constexpr (BIAS) { const int kq = (t) * 64 - qw0; \
            if (kq + 63 <= -128) ub = tab[0]; else if (kq - 31 >= 128) ub = tab[256]; \
            else { uni = false; _Pragma("unroll") for (int r = 0; r < 16; ++r) { const int i0 = kq + crow(r, hi) - r32 + 128; const int a0 = min(max(i0, 0), 256), a1 = min(max(i0 + 32, 0), 256); \
                    P0[r] = fmaf(P0[r], C, tab[a0]); P1[r] = fmaf(P1[r], C, tab[a1]); } } } \
        float pmax = P0[0]; _Pragma("unroll") for (int r = 1; r < 16; ++r) pmax = fmaxf(pmax, P0[r]); _Pragma("unroll") for (int r = 0; r < 16; ++r) pmax = fmaxf(pmax, P1[r]); \
        { auto rr = __builtin_amdgcn_permlane32_swap(__float_as_uint(pmax), __float_as_uint(pmax), false, false); pmax = fmaxf(__uint_as_float(rr[0]), __uint_as_float(rr[1])); } \
        if constexpr (BIAS) { if (uni) pmax = fmaf(pmax, C, ub); }     \
        const float KS = BIAS ? 1.0f : C;                   \
        float mn; \
        if (__builtin_expect(__all((pmax - m_reg) * KS <= 8.f * LOG2E), 1)) { mn = m_reg; ALPHA = 1.f; } \
        else { mn = fmaxf(m_reg, pmax); ALPHA = __builtin_amdgcn_exp2f((m_reg - mn) * KS); m_reg = mn; } \
        const float mnC = -mn * KS; \
        if constexpr (BIAS) { \
            if (uni) { const float cc = ub + mnC; _Pragma("unroll") for (int r = 0; r < 16; ++r) { P0[r] = fmaf(P0[r], C, cc); P1[r] = fmaf(P1[r], C, cc); } } \
            else { _Pragma("unroll") for (int r = 0; r < 16; ++r) { P0[r] += mnC; P1[r] += mnC; } } } \
        else { _Pragma("unroll") for (int r = 0; r < 16; ++r) { P0[r] = fmaf(P0[r], C, mnC); P1[r] = fmaf(P1[r], C, mnC); } } \
        _Pragma("unroll") for (int r = 0; r < 16; ++r) P0[r] = __builtin_amdgcn_exp2f(P0[r]); } while (0)
#define PK4(P, BASE, OUT) do { unsigned a0 = cvtpk(P[BASE + 0], P[BASE + 1]), a1 = cvtpk(P[BASE + 2], P[BASE + 3]);   \
    unsigned b0 = cvtpk(P[BASE + 4], P[BASE + 5]), b1 = cvtpk(P[BASE + 6], P[BASE + 7]);                              \
    auto r0 = __builtin_amdgcn_permlane32_swap(a0, b0, false, false); auto r1 = __builtin_amdgcn_permlane32_swap(a1, b1, false, false); \
    u32x4 w = {r0[0], r1[0], r0[1], r1[1]}; OUT = *reinterpret_cast<bf16x8*>(&w); } while (0)
#define SP_FIN(P0, P1, ALPHA) do { \
        _Pragma("unroll") for (int r = 0; r < 16; ++r) P1[r] = __builtin_amdgcn_exp2f(P1[r]); \
        float ps = 0.f; _Pragma("unroll") for (int r = 0; r < 16; ++r) ps += P0[r]; _Pragma("unroll") for (int r = 0; r < 16; ++r) ps += P1[r]; \
        { auto rr = __builtin_amdgcn_permlane32_swap(__float_as_uint(ps), __float_as_uint(ps), false, false); ps = __uint_as_float(rr[0]) + __uint_as_float(rr[1]); } \
        l_reg = l_reg * ALPHA + ps; \
        PK4(P0, 0, pa0); PK4(P0, 8, pa1); PK4(P1, 0, pa2); PK4(P1, 8, pa3); } while (0)
#define SP_PV(b) do { const int vb_ = vb0 + (b) * 16384; \
        pv_one<0>(o[0], vb_, pa0, pa1, pa2, pa3); pv_one<1>(o[1], vb_, pa0, pa1, pa2, pa3); pv_one<2>(o[2], vb_, pa0, pa1, pa2, pa3); pv_one<3>(o[3], vb_, pa0, pa1, pa2, pa3); } while (0)
#define SP_RESC(a) do { if (__any((a) < 1.f)) { if (hi == 0) al_l[r32] = (a); asm volatile("s_waitcnt lgkmcnt(0)" ::: "memory"); \
        _Pragma("unroll") for (int r = 0; r < 16; ++r) { const float a_ = al_l[crow(r, hi)]; _Pragma("unroll") for (int d = 0; d < 4; ++d) o[d][r] *= a_; } } } while (0)
    f32x16 pA0, pA1, pB0, pB1; float alA, alB; bf16x8 pa0, pa1, pa2, pa3;
    SP_LOAD(0); __syncthreads(); SP_WRITE(0); __syncthreads();
    SP_QKT(pA0, pA1, 0); SP_PART(pA0, pA1, alA, 0);
    SP_LOAD(1); SP_WRITE(1); __syncthreads();
#pragma nounroll
    for (int j = 1; j + 1 < NT; j += 2) {
        SBAR(); SP_QKT(pB0, pB1, 1);
        SP_FIN(pA0, pA1, alA); SBAR();
        SP_LOAD(j + 1); SBAR();
        SP_PV(0); SP_PART(pB0, pB1, alB, j);
        __syncthreads(); SP_WRITE(0);
        SP_RESC(alB); __syncthreads();
        SBAR(); SP_QKT(pA0, pA1, 0);
        SP_FIN(pB0, pB1, alB); SBAR();
        SP_LOAD(j + 2); SBAR();
        SP_PV(1); SP_PART(pA0, pA1, alA, j + 1);
        __syncthreads(); SP_WRITE(1);
        SP_RESC(alA); __syncthreads();
    }
    SBAR(); SP_QKT(pB0, pB1, 1);
    SP_FIN(pA0, pA1, alA); SBAR();
    SP_PV(0); SP_PART(pB0, pB1, alB, NT - 1);
    SP_RESC(alB);
    SP_FIN(pB0, pB1, alB); SBAR();
    SP_PV(1);
    if (hi == 0) li_l[r32] = l_reg;
    asm volatile("s_waitcnt lgkmcnt(0)" ::: "memory");
#pragma unroll
    for (int r = 0; r < 16; ++r) { const float rl = 1.0f / li_l[crow(r, hi)];
#pragma unroll
        for (int d = 0; d < 4; ++d) o[d][r] *= rl; }
#undef SP_LOAD
#undef SP_WRITE
#undef SP_QKT
#undef SP_PART
#undef PK4
#undef SP_FIN
#undef SP_PV
#undef SP_RESC
}

template <int DQK, bool MLAK, bool BIAS, int QL  , bool KPF  >
__device__ __forceinline__ void attn_core_sp3(f32x16 (&o)[4], const bf16x8 (&qr)[DQK / 16],
                                             const bf16_t* __restrict__ Kg, int ldk, const bf16_t* __restrict__ K2g, const bf16_t* __restrict__ Vg, int ldv,
                                             int nkeys, float C, int qw0, LAS char* lds) {
    constexpr int PITCH = DQK * 2, KBY = 64 * PITCH, CPR = DQK / 8, NKCH = DQK / 64, ND0 = DQK / 16;
    constexpr int L_V = 0, L_K = 49152, L_WS = L_K + 2 * KBY, L_TAB = L_WS + 2048, L_Q = L_TAB + 2048, QR = ND0 - QL;
    static_assert(!MLAK, "head-major K only");
    const int tid = otid(), wid = __builtin_amdgcn_readfirstlane(tid >> 6), lane = tid & 63, r32 = lane & 31, hi = lane >> 5;
    LAS char* V_lds = lds + L_V; LAS char* K_lds = lds + L_K;
    LAS float* wsf = (LAS float*)(lds + L_WS) + wid * 64; LAS float* li_l = wsf; LAS float* al_l = wsf + 32;
    const LAS float* tab = (const LAS float*)(lds + L_TAB);
    unsigned koff[NKCH], voff[2];
#pragma unroll
    for (int c = 0; c < NKCH; ++c) { const int pos = (wid * NKCH + c) * 1024 + lane * 16, row = pos / PITCH, sch = (pos % PITCH) >> 4;
        koff[c] = (unsigned)(row * ldk + ((sch ^ ((row >> 1) & 7)) << 3)); }
#pragma unroll
    for (int c = 0; c < 2; ++c) { const int pos = (wid * 2 + c) * 1024 + lane * 16, sub = pos >> 9, within = pos & 511;
        const int kk = (sub >> 2) * 8 + (within >> 6), k = (kk & ~0xC) | ((kk & 4) << 1) | ((kk & 8) >> 1), col = (sub & 3) * 32 + ((within & 63) >> 1);
        voff[c] = (unsigned)(k * ldv + col); }
    const int vb0 = (int)(unsigned)(uintptr_t)V_lds + v_rd_base(lane);
    const int kro = r32 * PITCH, kx = ((r32 >> 1) & 7) << 4;
    const LAS char* kcp[4];
#pragma unroll
    for (int m = 0; m < 4; ++m) kcp[m] = K_lds + kro + ((m * 32 + hi * 16) ^ kx);
    constexpr bool PNEG = (DQK == 192);
    f32x16 negm_ = f32x16{}; float nb_cur = 0.f;
    if (PNEG) asm volatile("" : "+v"(negm_));
    float m_reg = 0.f, l_reg = 0.f;
#pragma unroll
    for (int d = 0; d < 4; ++d) o[d] = f32x16{};
    const int NT = nkeys / 64;
    LAS char* q_lds = lds + L_Q + wid * (QL > 0 ? QL : 1) * 1024 + lane * 16;
    if constexpr (QL > 0) {
#pragma unroll
        for (int d0 = QR; d0 < ND0; ++d0) *(LAS bf16x8*)(q_lds + (d0 - QR) * 1024) = qr[d0];
    }
#define SP_SYNC() do { asm volatile("s_waitcnt vmcnt(0)" ::: "memory"); __syncthreads(); } while (0)
#define SP_DMA(t) do { const bf16_t* vt_ = Vg + (size_t)(t) * 64 * ldv; const bf16_t* kt_ = Kg + (size_t)(t) * 64 * ldk; const int sl_ = (t) % 3;   \
        _Pragma("unroll") for (int c = 0; c < NKCH; ++c) __builtin_amdgcn_global_load_lds((const unsigned*)(kt_ + koff[c]), (LAS unsigned*)(K_lds + ((t) & 1) * KBY + (wid * NKCH + c) * 1024), 16, 0, 0); \
        _Pragma("unroll") for (int c = 0; c < 2; ++c) __builtin_amdgcn_global_load_lds((const unsigned*)(vt_ + voff[c]), (LAS unsigned*)(V_lds + sl_ * 16384 + (wid * 2 + c) * 1024), 16, 0, 0); } while (0)
#define SP_KRD(dst, d0_) do { const LAS char* ka_ = kcp[(d0_) & 3] + ks_ + ((d0_) >> 2) * 128; dst[0] = *(const LAS bf16x8*)(ka_); dst[1] = *(const LAS bf16x8*)(ka_ + 32 * PITCH); } while (0)
#define SP_QMM(src, d0_) do { bf16x8 qf_; if ((d0_) < QR) qf_ = qr[(d0_) < QR ? (d0_) : 0]; else qf_ = *(const LAS bf16x8*)(q_lds + ((d0_) - QR) * 1024); \
        if ((d0_) == 0) { P0_ = __builtin_amdgcn_mfma_f32_32x32x16_bf16(src[0], qf_, negm_, 0, 0, 0); P1_ = __builtin_amdgcn_mfma_f32_32x32x16_bf16(src[1], qf_, negm_, 0, 0, 0); } \
        else { P0_ = __builtin_amdgcn_mfma_f32_32x32x16_bf16(src[0], qf_, P0_, 0, 0, 0); P1_ = __builtin_amdgcn_mfma_f32_32x32x16_bf16(src[1], qf_, P1_, 0, 0, 0); } } while (0)
#define SP_QKT(P0, P1, b, t) do { const int ks_ = (b) * KBY; f32x16 P0_, P1_; \
        { float nb_ = -m_reg;                \
          if constexpr (BIAS) { const int kq_ = (t) * 64 - qw0; if (kq_ + 63 <= -128) nb_ += tab[0]; else if (kq_ - 31 >= 128) nb_ += tab[447]; } \
          if (!PNEG || __any(nb_ != nb_cur)) { nb_cur = nb_; _Pragma("unroll") for (int r = 0; r < 16; ++r) negm_[r] = nb_; if (PNEG) asm volatile("" : "+v"(negm_)); } }     \
        if constexpr (KPF) { bf16x8 kfa[2], kfb[2]; SP_KRD(kfa, 0); \
            _Pragma("unroll") for (int d0 = 0; d0 < ND0; ++d0) { \
                if (d0 + 1 < ND0) { if (d0 & 1) SP_KRD(kfa, d0 + 1); else SP_KRD(kfb, d0 + 1); } \
                __builtin_amdgcn_sched_barrier(0x6); \
                if (d0 & 1) SP_QMM(kfb, d0); else SP_QMM(kfa, d0); \
                __builtin_amdgcn_sched_barrier(0x6); } } \
        else { _Pragma("unroll") for (int d0 = 0; d0 < ND0; ++d0) { bf16x8 kf_[2]; SP_KRD(kf_, d0); SP_QMM(kf_, d0); if ((d0 & 1) == 1) __builtin_amdgcn_sched_barrier(0x6); } } \
        P0 = P0_; P1 = P1_; } while (0)
#define SP_PART(P0, P1, ALPHA, t, FIRST) do { \
        if constexpr (BIAS) { const int kq = (t) * 64 - qw0; \
            if (!(kq + 63 <= -128) && !(kq - 31 >= 128)) { const LAS float* tb_ = tab + (kq + 224 - r32 + 4 * hi);     \
                _Pragma("unroll") for (int r = 0; r < 16; ++r) { P0[r] += tb_[(r & 3) + 8 * (r >> 2)]; P1[r] += tb_[(r & 3) + 8 * (r >> 2) + 32]; } } } \
        float pmax = P0[0]; _Pragma("unroll") for (int r = 1; r < 16; ++r) pmax = fmaxf(pmax, P0[r]); _Pragma("unroll") for (int r = 0; r < 16; ++r) pmax = fmaxf(pmax, P1[r]); \
        { auto rr = __builtin_amdgcn_permlane32_swap(__float_as_uint(pmax), __float_as_uint(pmax), false, false); pmax = fmaxf(__uint_as_float(rr[0]), __uint_as_float(rr[1])); } \
          \
        if ((FIRST) || !__builtin_expect(__all(pmax <= 8.f * LOG2E), 1)) { const float dl = (FIRST) ? pmax : fmaxf(pmax, 0.f); m_reg += dl; \
            _Pragma("unroll") for (int r = 0; r < 16; ++r) { P0[r] -= dl; P1[r] -= dl; } \
            ALPHA = (FIRST) ? 1.f : __builtin_amdgcn_exp2f(-dl); } \
        else ALPHA = 1.f; \
        _Pragma("unroll") for (int r = 0; r < 16; ++r) P0[r] = __builtin_amdgcn_exp2f(P0[r]); } while (0)
#define PK4(P, BASE, OUT) do { unsigned a0 = cvtpk(P[BASE + 0], P[BASE + 1]), a1 = cvtpk(P[BASE + 2], P[BASE + 3]);   \
    unsigned b0 = cvtpk(P[BASE + 4], P[BASE + 5]), b1 = cvtpk(P[BASE + 6], P[BASE + 7]);                              \
    auto r0 = __builtin_amdgcn_permlane32_swap(a0, b0, false, false); auto r1 = __builtin_amdgcn_permlane32_swap(a1, b1, false, false); \
    u32x4 w = {r0[0], r1[0], r0[1], r1[1]}; OUT = *reinterpret_cast<bf16x8*>(&w); } while (0)
#define SP_FIN(P0, P1, ALPHA) do { \
        _Pragma("unroll") for (int r = 0; r < 16; ++r) P1[r] = __builtin_amdgcn_exp2f(P1[r]); \
        float ps = 0.f; _Pragma("unroll") for (int r = 0; r < 16; ++r) ps += P0[r]; _Pragma("unroll") for (int r = 0; r < 16; ++r) ps += P1[r]; \
        { auto rr = __builtin_amdgcn_permlane32_swap(__float_as_uint(ps), __float_as_uint(ps), false, false); ps = __uint_as_float(rr[0]) + __uint_as_float(rr[1]); } \
        l_reg = l_reg * ALPHA + ps; \
        PK4(P0, 0, pa0); PK4(P0, 8, pa1); PK4(P1, 0, pa2); PK4(P1, 8, pa3); } while (0)
#define SP_PV(b) do { const int vb_ = vb0 + (b) * 16384; \
        pv_one<0>(o[0], vb_, pa0, pa1, pa2, pa3); pv_one<1>(o[1], vb_, pa0, pa1, pa2, pa3); pv_one<2>(o[2], vb_, pa0, pa1, pa2, pa3); pv_one<3>(o[3], vb_, pa0, pa1, pa2, pa3); } while (0)
#define SP_RESC(a) do { if (__any((a) < 1.f)) { if (hi == 0) al_l[r32] = (a); asm volatile("s_waitcnt lgkmcnt(0)" ::: "memory"); \
        _Pragma("unroll") for (int r = 0; r < 16; ++r) { const float a_ = al_l[crow(r, hi)]; _Pragma("unroll") for (int d = 0; d < 4; ++d) o[d][r] *= a_; } } } while (0)
    f32x16 pA0, pA1, pB0, pB1; float alA, alB; bf16x8 pa0, pa1, pa2, pa3;
    SP_SYNC(); SP_DMA(0); SP_SYNC();
    SP_QKT(pA0, pA1, 0, 0); SP_PART(pA0, pA1, alA, 0, true);
    SP_DMA(1); SP_SYNC();
#pragma nounroll
    for (int j = 1; j + 1 < NT; j += 2) {
        SBAR(); SP_QKT(pB0, pB1, j & 1, j);
        SP_FIN(pA0, pA1, alA); SBAR();
        SP_DMA(j + 1); SBAR();
        SP_PV((j - 1) % 3); SP_PART(pB0, pB1, alB, j, false);
        SP_RESC(alB); SP_SYNC();
        SBAR(); SP_QKT(pA0, pA1, (j + 1) & 1, j + 1);
        SP_FIN(pB0, pB1, alB); SBAR();
        if (j + 2 < NT) SP_DMA(j + 2); SBAR();
        SP_PV(j % 3); SP_PART(pA0, pA1, alA, j + 1, false);
        SP_RESC(alA); SP_SYNC();
    }
    SBAR(); SP_QKT(pB0, pB1, (NT - 1) & 1, NT - 1);
    SP_FIN(pA0, pA1, alA); SBAR();
    SP_PV((NT - 2) % 3); SP_PART(pB0, pB1, alB, NT - 1, false);
    SP_RESC(alB);
    SP_FIN(pB0, pB1, alB); SBAR();
    SP_PV((NT - 1) % 3);
    if (hi == 0) li_l[r32] = l_reg;
    asm volatile("s_waitcnt lgkmcnt(0)" ::: "memory");
#pragma unroll
    for (int r = 0; r < 16; ++r) { const float rl = 1.0f / li_l[crow(r, hi)];
#pragma unroll
        for (int d = 0; d < 4; ++d) o[d][r] *= rl; }
#undef SP_DMA
#undef SP_SYNC
#undef SP_QKT
#undef SP_KRD
#undef SP_QMM
#undef SP_PART
#undef PK4
#undef SP_FIN
#undef SP_PV
#undef SP_RESC
}

template <int DQK>
__device__ __forceinline__ void attn_core_x(f32x16 (&o)[4], const bf16x8 (&qr)[DQK / 16], const bf16_t* __restrict__ Kg, int ldk, const bf16_t* __restrict__ Vg, int ldv,
                                            int nkeys, float C, LAS char* lds) {
    constexpr int PITCH = DQK * 2, KBY = 64 * PITCH, NKCH = DQK / 64, ND0 = DQK / 16;
    constexpr int L_V = 0, L_K = 32768, L_WS = L_K + 2 * KBY;
    const int tid = otid(), wid = __builtin_amdgcn_readfirstlane(tid >> 6), lane = tid & 63, r32 = lane & 31, hi = lane >> 5;
    LAS char* V_lds = lds + L_V; LAS char* K_lds = lds + L_K;
    LAS float* wsf = (LAS float*)(lds + L_WS) + wid * 64; LAS float* li_l = wsf; LAS float* al_l = wsf + 32;
    unsigned koff[NKCH], voff[2];
#pragma unroll
    for (int c = 0; c < NKCH; ++c) { const int pos = (wid * NKCH + c) * 1024 + lane * 16, row = pos / PITCH, sch = (pos % PITCH) >> 4;
        koff[c] = (unsigned)(row * ldk + ((sch ^ ((row >> 1) & 7)) << 3)); }
#pragma unroll
    for (int c = 0; c < 2; ++c) { const int pos = (wid * 2 + c) * 1024 + lane * 16, sub = pos >> 9, within = pos & 511;
        const int kk = (sub >> 2) * 8 + (within >> 6), k = (kk & ~0xC) | ((kk & 4) << 1) | ((kk & 8) >> 1), col = (sub & 3) * 32 + ((within & 63) >> 1);
        voff[c] = (unsigned)(k * ldv + col); }
    const int vb0 = (int)(unsigned)(uintptr_t)V_lds + v_rd_base(lane);
    const int kro = r32 * PITCH, kx = ((r32 >> 1) & 7) << 4;
    const LAS char* kcp[4];
#pragma unroll
    for (int m = 0; m < 4; ++m) kcp[m] = K_lds + kro + ((m * 32 + hi * 16) ^ kx);
    float m_reg = -1e30f, l_reg = 0.f;
#pragma unroll
    for (int d = 0; d < 4; ++d) o[d] = f32x16{};
    const int NT = nkeys / 64;
#define X_DMA(t) do { const bf16_t* vt_ = Vg + (size_t)(t) * 64 * ldv; const bf16_t* kt_ = Kg + (size_t)(t) * 64 * ldk; const int sl_ = (t) & 1; \
        _Pragma("unroll") for (int c = 0; c < NKCH; ++c) __builtin_amdgcn_global_load_lds((const unsigned*)(kt_ + koff[c]), (LAS unsigned*)(K_lds + sl_ * KBY + (wid * NKCH + c) * 1024), 16, 0, 0); \
        _Pragma("unroll") for (int c = 0; c < 2; ++c) __builtin_amdgcn_global_load_lds((const unsigned*)(vt_ + voff[c]), (LAS unsigned*)(V_lds + sl_ * 16384 + (wid * 2 + c) * 1024), 16, 0, 0); } while (0)
#define X_BAR() do { SBAR(); asm volatile("s_waitcnt lgkmcnt(0)\n\ts_barrier" ::: "memory"); SBAR(); } while (0)
    asm volatile("s_waitcnt vmcnt(0)" ::: "memory");
    __syncthreads();
    X_DMA(0);
#pragma nounroll
    for (int j = 0; j < NT; ++j) {
        if (j + 1 < NT) { X_DMA(j + 1); asm volatile("s_waitcnt vmcnt(%0)" :: "n"(NKCH + 2) : "memory"); }
        else asm volatile("s_waitcnt vmcnt(0)" ::: "memory");
        X_BAR();
        const int ks_ = (j & 1) * KBY;
        f32x16 p0 = f32x16{}, p1 = f32x16{};
        {
#define X_KRD(dst, d0_) do { const LAS char* ka_ = kcp[(d0_) & 3] + ks_ + ((d0_) >> 2) * 128; dst[0] = *(const LAS bf16x8*)(ka_); dst[1] = *(const LAS bf16x8*)(ka_ + 32 * PITCH); } while (0)
            bf16x8 kfa[2], kfb[2]; X_KRD(kfa, 0);
#pragma unroll
            for (int d0 = 0; d0 < ND0; ++d0) {
                if (d0 + 1 < ND0) { if (d0 & 1) X_KRD(kfa, d0 + 1); else X_KRD(kfb, d0 + 1); }
                __builtin_amdgcn_sched_barrier(0x6);
                if (d0 & 1) { p0 = __builtin_amdgcn_mfma_f32_32x32x16_bf16(kfb[0], qr[d0], p0, 0, 0, 0); p1 = __builtin_amdgcn_mfma_f32_32x32x16_bf16(kfb[1], qr[d0], p1, 0, 0, 0); }
                else { p0 = __builtin_amdgcn_mfma_f32_32x32x16_bf16(kfa[0], qr[d0], p0, 0, 0, 0); p1 = __builtin_amdgcn_mfma_f32_32x32x16_bf16(kfa[1], qr[d0], p1, 0, 0, 0); }
                __builtin_amdgcn_sched_barrier(0x6); }
#undef X_KRD
        }
        float pmax = fmaxf(p0[0], p1[0]);
#pragma unroll
        for (int r = 1; r < 16; ++r) pmax = fmaxf(fmaxf(pmax, p0[r]), p1[r]);
        { auto rr = __builtin_amdgcn_permlane32_swap(__float_as_uint(pmax), __float_as_uint(pmax), false, false); pmax = fmaxf(__uint_as_float(rr[0]), __uint_as_float(rr[1])); }
        pmax *= C;
        const float mn = fmaxf(m_reg, pmax); const float alpha = __builtin_amdgcn_exp2f(m_reg - mn); m_reg = mn;
        float ps = 0.f;
#pragma unroll
        for (int r = 0; r < 16; ++r) { p0[r] = __builtin_amdgcn_exp2f(fmaf(p0[r], C, -mn)); p1[r] = __builtin_amdgcn_exp2f(fmaf(p1[r], C, -mn)); ps += p0[r] + p1[r]; }
        { auto rr = __builtin_amdgcn_permlane32_swap(__float_as_uint(ps), __float_as_uint(ps), false, false); ps = __uint_as_float(rr[0]) + __uint_as_float(rr[1]); }
        l_reg = l_reg * alpha + ps;
        if (__any(alpha < 1.f)) { if (hi == 0) al_l[r32] = alpha; asm volatile("s_waitcnt lgkmcnt(0)" ::: "memory");
#pragma unroll
            for (int r = 0; r < 16; ++r) { const float a = al_l[crow(r, hi)];
#pragma unroll
                for (int d = 0; d < 4; ++d) o[d][r] *= a; } }
        bf16x8 pa0, pa1, pa2, pa3;
#define PK4(P, BASE, OUT) do { unsigned a0 = cvtpk(P[BASE + 0], P[BASE + 1]), a1 = cvtpk(P[BASE + 2], P[BASE + 3]);   \
    unsigned b0 = cvtpk(P[BASE + 4], P[BASE + 5]), b1 = cvtpk(P[BASE + 6], P[BASE + 7]);                              \
    auto r0 = __builtin_amdgcn_permlane32_swap(a0, b0, false, false); auto r1 = __builtin_amdgcn_permlane32_swap(a1, b1, false, false); \
    u32x4 w = {r0[0], r1[0], r0[1], r1[1]}; OUT = *reinterpret_cast<bf16x8*>(&w); } while (0)
        PK4(p0, 0, pa0); PK4(p0, 8, pa1); PK4(p1, 0, pa2); PK4(p1, 8, pa3);
#undef PK4
        SBAR();
        const int vb_ = vb0 + (j & 1) * 16384;
        pv_one<0>(o[0], vb_, pa0, pa1, pa2, pa3); pv_one<1>(o[1], vb_, pa0, pa1, pa2, pa3); pv_one<2>(o[2], vb_, pa0, pa1, pa2, pa3); pv_one<3>(o[3], vb_, pa0, pa1, pa2, pa3);
        X_BAR();
    }
    if (hi == 0) li_l[r32] = l_reg;
    asm volatile("s_waitcnt lgkmcnt(0)" ::: "memory");
#pragma unroll
    for (int r = 0; r < 16; ++r) { const float rl = 1.0f / li_l[crow(r, hi)];
#pragma unroll
        for (int d = 0; d < 4; ++d) o[d][r] *= rl; }
#undef X_DMA
#undef X_BAR
}

__device__ __forceinline__ void store_o(const f32x16 (&o)[4], bf16_t* Ob, int ldo, int r32, int hi) {
#pragma unroll
    for (int r = 0; r < 16; ++r) { bf16_t* p = Ob + (size_t)crow(r, hi) * ldo + r32;
#pragma unroll
        for (int d0 = 0; d0 < 4; ++d0) p[d0 * 32] = (bf16_t)(cvtpk(o[d0][r], 0.f) & 0xffffu); }
}
}

__device__ __forceinline__ void self_unit(int u, int& seqbase, int& S, int& h, int& qb) {
    if (u < 2048) { const int round = u >> 8, v = u & 255, x = v >> 5, j = v & 31; const int pair = x * 8 + round; S = SS; seqbase = MP + (pair >> 3) * SS; h = pair & 7; qb = j; }
    else { const int u2 = u - 2048, round = u2 >> 8, v = u2 & 255, x = v >> 5, j = v & 31; const int pair = x * 4 + round * 2 + (j >> 4); S = SP; seqbase = (pair >> 3) * SP; h = pair & 7; qb = j & 15; }
}

__device__ __forceinline__ void phase_mla_attn(const Params& P, LAS char* lds, int vcu, int G) {
    const int tid = otid(), wid = tid >> 6, lane = tid & 63, r32 = lane & 31, hi = lane >> 5;
    const bf16_t* Q = (const bf16_t*)(P.ws + O_Q); const bf16_t* KH = (const bf16_t*)(P.ws + O_KH); const bf16_t* VH = (const bf16_t*)(P.ws + O_VH);
    bf16_t* O = (bf16_t*)(P.ws + O_O);
    const float* cosT = (const float*)(P.ws + O_COS); const float* sinT = (const float*)(P.ws + O_SIN);
    const float C = 0.07216878364870323f * LOG2E;
#if PROBE_SEL
    if (blockIdx.x == 0 && tid == 0) { unsigned long long* pb = (unsigned long long*)(P.ws + 4096); for (int i = 0; i < 16; ++i) pb[i] = 0; pb[16] = __builtin_readcyclecounter(); pb[17] = __builtin_amdgcn_s_memrealtime(); }
    __syncthreads();
#endif
#pragma nounroll
    for (int u = vcu; u < 2560; u += G) {
        int seqbase, S, h, qb; self_unit(u, seqbase, S, h, qb);
        const int pos = qb * 256 + wid * 32 + r32; const size_t row = (size_t)seqbase + pos;
        const bf16_t* qp = Q + row * 1536 + h * 192 + hi * 8;
        bf16x8 qr[12];
#pragma unroll
        for (int d0 = 0; d0 < 12; ++d0) qr[d0] = *(const bf16x8*)(qp + d0 * 16);
#pragma unroll
        for (int pr = 0; pr < 2; ++pr) { const int i0 = pr * 16 + hi * 8;
            const f32x4 c0 = *(const f32x4*)(cosT + pos * 32 + i0), c1 = *(const f32x4*)(cosT + pos * 32 + i0 + 4);
            const f32x4 s0 = *(const f32x4*)(sinT + pos * 32 + i0), s1 = *(const f32x4*)(sinT + pos * 32 + i0 + 4);
            const float cs[8] = {c0.x, c0.y, c0.z, c0.w, c1.x, c1.y, c1.z, c1.w}, sn[8] = {s0.x, s0.y, s0.z, s0.w, s1.x, s1.y, s1.z, s1.w};
            const bf16x8 x1 = qr[8 + pr], x2 = qr[10 + pr]; float o1[8], o2[8];
#pragma unroll
            for (int e = 0; e < 8; ++e) { const float a = bf1(x1[e]), b = bf1(x2[e]); o1[e] = a * cs[e] - b * sn[e]; o2[e] = a * sn[e] + b * cs[e]; }
            u32x4 w1 = {cvtpk(o1[0], o1[1]), cvtpk(o1[2], o1[3]), cvtpk(o1[4], o1[5]), cvtpk(o1[6], o1[7])};
            u32x4 w2 = {cvtpk(o2[0], o2[1]), cvtpk(o2[2], o2[3]), cvtpk(o2[4], o2[5]), cvtpk(o2[6], o2[7])};
            qr[8 + pr] = __builtin_bit_cast(bf16x8, w1); qr[10 + pr] = __builtin_bit_cast(bf16x8, w2); }
#pragma unroll
        for (int d0 = 0; d0 < 12; ++d0) qr[d0] = scale_frag(qr[d0], C);
        f32x16 o[4];
        att::attn_core_sp3<192, false, false, 7, true>(o, qr, KH + ((size_t)h * MT + seqbase) * 192, 192, nullptr, VH + ((size_t)h * MT + seqbase) * 128, 128, S, C, 0, lds);
        att::store_o(o, O + ((size_t)seqbase + qb * 256 + wid * 32) * 1024 + h * 128, 1024, r32, hi);
    }
#if PROBE_SEL
    if (blockIdx.x == 0 && tid == 0) { unsigned long long* pb = (unsigned long long*)(P.ws + 4096); pb[18] = __builtin_readcyclecounter(); pb[19] = __builtin_amdgcn_s_memrealtime(); }
#endif
}

__device__ __forceinline__ void phase_xattn(const Params& P, int layer, LAS char* lds, int vcu, int G) {
    const int tid = otid(), wid = tid >> 6, lane = tid & 63, r32 = lane & 31, hi = lane >> 5;
    const bf16_t* XQ = (const bf16_t*)(P.ws + O_XQ); const bf16_t* MKV = (const bf16_t*)(P.ws + O_MKV) + (size_t)layer * NMR * 2048;
    bf16_t* O = (bf16_t*)(P.ws + O_O);
    const float C = 0.0625f * LOG2E;
#pragma nounroll
    for (int u = vcu; u < 2560; u += G) {
        const int vh = u & 1, h = (u >> 1) & 3, t = u >> 3; const int tok0 = t * 256;
        const int batch = tok0 < MP ? tok0 / SP : 4 + (tok0 - MP) / SS;
        const size_t row = (size_t)tok0 + wid * 32 + r32;
        const bf16_t* qp = XQ + row * 1024 + h * 256 + hi * 8;
        bf16x8 qr[16];
#pragma unroll
        for (int d0 = 0; d0 < 16; ++d0) qr[d0] = *(const bf16x8*)(qp + d0 * 16);
        const bf16_t* kb = MKV + (size_t)batch * 256 * 2048 + h * 256;
        f32x16 o[4];
        att::attn_core_x<256>(o, qr, kb, 2048, kb + 1024 + vh * 128, 2048, 256, C, lds);
        att::store_o(o, O + ((size_t)tok0 + wid * 32) * 1024 + h * 256 + vh * 128, 1024, r32, hi);
    }
}

__device__ __forceinline__ void phase_diff_attn(const Params& P, LAS char* lds, int vcu, int G) {
    const int tid = otid(), wid = tid >> 6, lane = tid & 63, r32 = lane & 31, hi = lane >> 5;
    const bf16_t* DQ = (const bf16_t*)(P.ws + O_DQ); const bf16_t* DKH = (const bf16_t*)(P.ws + O_DKH); const bf16_t* DVH = (const bf16_t*)(P.ws + O_DVH); bf16_t* O = (bf16_t*)(P.ws + O_O);
    const float* lam = P.in[13]; const float* subln = P.in[14]; const float* rbt = P.in[5];
    const float la = wave_sum(lam[lane] * lam[64 + lane]), lb = wave_sum(lam[128 + lane] * lam[192 + lane]);
    const float lam_full = expf(la) - expf(lb) + LAMBDA_INIT;
    const float C = 0.125f * LOG2E;
    LAS float* tab = (LAS float*)(lds + 67584);
    float sg[4];
#pragma unroll
    for (int d0 = 0; d0 < 4; ++d0) sg[d0] = subln[d0 * 32 + r32] * (1.0f - LAMBDA_INIT);
#pragma nounroll
    for (int u = vcu; u < 2560; u += G) {
        int seqbase, S, h, qb; self_unit(u, seqbase, S, h, qb);
        __syncthreads();
        for (int idx = tid; idx < 448; idx += 512) { const int rel = min(max(idx - 224, -128), 128), n = rel < 0 ? -rel : rel;
            int b = n < 8 ? n : (n < 12 ? 8 : n < 16 ? 9 : n < 23 ? 10 : n < 32 ? 11 : n < 46 ? 12 : n < 64 ? 13 : n < 91 ? 14 : 15);
            if (rel > 0) b += 16;
            tab[idx] = rbt[b * 8 + h] * LOG2E; }
        const int qw0 = qb * 256 + wid * 32; const size_t row = (size_t)seqbase + qw0 + r32;
        const bf16_t* kb = DKH + ((size_t)h * MT + seqbase) * 128; const bf16_t* vb = DVH + ((size_t)h * MT + seqbase) * 128;
        f32x16 oa[4], ob[4];
        LAS unsigned* stash = (LAS unsigned*)(lds + 69632) + tid;
        { bf16x8 qr[4]; const bf16_t* qp = DQ + row * 1024 + h * 128 + hi * 8;
#pragma unroll
          for (int d0 = 0; d0 < 4; ++d0) qr[d0] = scale_frag(*(const bf16x8*)(qp + d0 * 16), C);
          att::attn_core_sp3<64, false, true, 0, true>(oa, qr, kb, 128, nullptr, vb, 128, S, C, qw0, lds); }
#pragma unroll
        for (int d0 = 0; d0 < 4; ++d0)
#pragma unroll
            for (int r = 0; r < 16; r += 2) stash[(d0 * 8 + (r >> 1)) * 512] = cvtpk(oa[d0][r], oa[d0][r + 1]);
        { bf16x8 qr[4]; const bf16_t* qp = DQ + row * 1024 + h * 128 + 64 + hi * 8;
#pragma unroll
          for (int d0 = 0; d0 < 4; ++d0) qr[d0] = scale_frag(*(const bf16x8*)(qp + d0 * 16), C);
          att::attn_core_sp3<64, false, true, 0, true>(ob, qr, kb + 64, 128, nullptr, vb, 128, S, C, qw0, lds); }
#pragma unroll
        for (int r = 0; r < 16; ++r) { float s = 0.f;
#pragma unroll
            for (int d0 = 0; d0 < 4; ++d0) { const unsigned w = stash[(d0 * 8 + (r >> 1)) * 512]; const float a = (r & 1) ? bfhi(w) : bflo(w); const float v = a - lam_full * ob[d0][r]; oa[d0][r] = v; s += v * v; }
            s = half_sum(s);
            const float rs = 1.0f / sqrtf(s * (1.f / 128.f) + EPS);
#pragma unroll
            for (int d0 = 0; d0 < 4; ++d0) oa[d0][r] *= rs * sg[d0]; }
        att::store_o(oa, O + ((size_t)seqbase + qw0) * 1024 + h * 128, 1024, r32, hi);
    }
}

struct GemmDesc { const bf16_t* A; const bf16_t* Bt; bf16_t* C; int M, N, K, act; int mode; bf16_t* C2; bf16_t* C3; };
__device__ __forceinline__ int gemm_desc(int ph, int sub, unsigned char* ws, GemmDesc& d) {
#define BP(off) ((bf16_t*)(ws + (off)))
    const int L = ph >= 14 ? 1 : 0;
    switch (ph) {
    case 1:
        if (sub < 2) { d = GemmDesc{BP(O_MEMN) + (size_t)sub * NMR * 1024, BP(O_W_XKV + (size_t)sub * 4 * MiB), BP(O_MKV) + (size_t)sub * NMR * 2048, NMR, 2048, 1024, 0, 0, nullptr, nullptr}; }
        else { d = GemmDesc{BP(O_XH), BP(O_W_MLA_IN), BP(O_C), MT, 768, 1024, 0, 0, nullptr, nullptr}; }
        return 3;
    case 3:
        if (sub == 0) d = GemmDesc{BP(O_CNQ), BP(O_W_MLA_UQ), BP(O_Q), MT, 1536, 256, 0, 0, nullptr, nullptr};
        else d = GemmDesc{BP(O_CNKV), BP(O_W_MLA_UKV), nullptr, MT, 2048, 256, 0, 1, BP(O_KH), BP(O_VH)};
        return 2;
    case 5: d = GemmDesc{BP(O_O), BP(O_W_MLA_O), BP(O_XH), MT, 1024, 1024, 0, 0, nullptr, nullptr}; return 1;
    case 7: case 18: d = GemmDesc{BP(O_XH), BP(O_W_XQ + (size_t)L * 2 * MiB), BP(O_XQ), MT, 1024, 1024, 0, 0, nullptr, nullptr}; return 1;
    case 9: case 20: d = GemmDesc{BP(O_O), BP(O_W_XO + (size_t)L * 2 * MiB), BP(O_XH), MT, 1024, 1024, 0, 0, nullptr, nullptr}; return 1;
    case 11: case 22: d = GemmDesc{BP(O_XH), BP(O_W_1 + (size_t)L * 8 * MiB), BP(O_ACT), MT, 4096, 1024, 1, 0, nullptr, nullptr}; return 1;
    case 12: case 23: d = GemmDesc{BP(O_ACT), BP(O_W_2 + (size_t)L * 8 * MiB), BP(O_XH), MT, 1024, 4096, 0, 0, nullptr, nullptr}; return 1;
    case 14: d = GemmDesc{BP(O_XH), BP(O_W_DIFF_IN), BP(O_DQ), MT, 3072, 1024, 0, 2, BP(O_DKH), BP(O_DVH)}; return 1;
    case 16: d = GemmDesc{BP(O_O), BP(O_W_DIFF_O), BP(O_XH), MT, 1024, 1024, 0, 0, nullptr, nullptr}; return 1;
    default: return 0;
    }
#undef BP
}

#define XB_TMO      128
#define XB_XCNT(j)  (256  + 64 * (j))
#define XB_XSUB(j)  (1280 + 64 * (j))
#define XB_XGEN(j)  (2304 + 64 * (j))
#define XB_TOP      3328
#define XB_TOPGEN   3392
#define XCD_BAR_WORDS 3456
#define XB_SPIN_CAP (1u << 18)

__device__ __forceinline__ unsigned xb_ld(unsigned* p)              { return __hip_atomic_load(p, __ATOMIC_RELAXED, __HIP_MEMORY_SCOPE_AGENT); }
__device__ __forceinline__ unsigned xb_add(unsigned* p, unsigned v) { return __hip_atomic_fetch_add(p, v, __ATOMIC_RELAXED, __HIP_MEMORY_SCOPE_AGENT); }
__device__ __forceinline__ unsigned xb_xcc_id() { return (unsigned)__builtin_amdgcn_s_getreg((3 << 11) | 20) & 0xFu; }
#define XB_SPIN(cond, bar) do { unsigned _sp = 0; while (cond) { __builtin_amdgcn_s_sleep(1); \
    if ((++_sp & 255u) == 0u) { if (xb_ld(&(bar)[XB_TMO])) break; if (_sp > XB_SPIN_CAP) { atomicAdd(&(bar)[XB_TMO], 1u); break; } } } } while (0)

struct XcdBarrier {
    unsigned* bar; unsigned x;
    volatile LAS unsigned* st;
};

__device__ __forceinline__ XcdBarrier xcd_barrier_post(unsigned* bar, volatile LAS unsigned* st) {
    XcdBarrier b; b.bar = bar; b.x = xb_xcc_id(); b.st = st;
    if (threadIdx.x == 0) (void)xb_add(&bar[XB_XCNT(b.x)], 1u);
    return b;
}
__device__ __forceinline__ void xcd_barrier_complete(unsigned* bar, unsigned x, unsigned& nloc, unsigned& nx) {
    const unsigned G = gridDim.x * gridDim.y * gridDim.z;
    unsigned sum, cnt, mine, sp = 0u;
    for (;;) {
        sum = 0u; cnt = 0u; mine = 0u;
#pragma unroll
        for (unsigned j = 0; j < 16; ++j) { const unsigned c = xb_ld(&bar[XB_XCNT(j)]); sum += c; cnt += (c > 0u) ? 1u : 0u; mine = (j == x) ? c : mine; }
        if (sum == G) break;
        __builtin_amdgcn_s_sleep(1);
        if ((++sp & 255u) == 0u) { if (xb_ld(&bar[XB_TMO])) break; if (sp > XB_SPIN_CAP) { atomicAdd(&bar[XB_TMO], 1u); break; } }
    }
    nloc = mine > 0u ? mine : 1u; nx = cnt > 0u ? cnt : 1u;
}

__device__ __forceinline__ void xcd_barrier(const XcdBarrier& b) {
    asm volatile("s_waitcnt vmcnt(0)" ::: "memory");
    __syncthreads();
    if (threadIdx.x == 0) {
        unsigned* bar = b.bar;
        __builtin_amdgcn_s_waitcnt(0);
        unsigned nloc = b.st[0], nx = b.st[1];
        if (nloc == 0u) { xcd_barrier_complete(bar, b.x, nloc, nx); b.st[0] = nloc; b.st[1] = nx; }
        const unsigned old = xb_add(&bar[XB_XSUB(b.x)], 1u);
        const unsigned gen = old / nloc;
        if (old + 1u == (gen + 1u) * nloc) {
            __builtin_amdgcn_fence(__ATOMIC_RELEASE, "agent");
            asm volatile("s_waitcnt vmcnt(0)" ::: "memory");
            const unsigned og = xb_add(&bar[XB_TOP], 1u);
            const unsigned tg = og / nx;
            if (og + 1u == (tg + 1u) * nx) xb_add(&bar[XB_TOPGEN], 1u);
            else XB_SPIN(xb_ld(&bar[XB_TOPGEN]) == tg, bar);
            __builtin_amdgcn_fence(__ATOMIC_ACQUIRE, "agent");
            xb_add(&bar[XB_XGEN(b.x)], 1u);
            asm volatile("s_waitcnt vmcnt(0)" ::: "memory");
        } else {
            XB_SPIN(xb_ld(&bar[XB_XGEN(b.x)]) == gen, bar);
            __builtin_amdgcn_fence(__ATOMIC_ACQUIRE, "agent");
            asm volatile("s_waitcnt vmcnt(0)" ::: "memory");
        }
    }
    __syncthreads();
}

__global__ void __launch_bounds__(512, 2) mk_fwd(Params P) {
    extern __shared__ __attribute__((aligned(16))) unsigned char lds_raw[];
    cg::grid_group grid = cg::this_grid();
    LAS unsigned char* lds = (LAS unsigned char*)lds_raw;
    const int G = gridDim.x, bx = blockIdx.x;
    const int vcu = (G % 8 == 0) ? (bx % 8) * (G / 8) + bx / 8 : bx;
    const int NGW = G * 8;
    const float* gains = P.in[4];
    volatile LAS unsigned* bst = (volatile LAS unsigned*)(lds + LDS_BYTES - 16);
    if (threadIdx.x < 4) bst[threadIdx.x] = 0u;
    __syncthreads();
    (void)xcd_barrier_post((unsigned*)(P.ws + 65536), bst);
    int rep = 0;
#pragma nounroll
    for (int ph = 0; ph < NPH_LIMIT;) {
        if (ph == 0) phase_prologue(P, lds, vcu, NGW);
        else if (ph == 2) phase_cnorm(P, vcu, NGW);
#ifndef SKIP_MLA
        else if (ph == 4) phase_mla_attn(P, (LAS char*)lds, vcu, G);
#endif
#ifndef SKIP_DIFF
        else if (ph == 15) phase_diff_attn(P, (LAS char*)lds, vcu, G);
#endif
#ifndef SKIP_XATTN
        else if (ph == 8 || ph == 19) phase_xattn(P, ph == 8 ? 0 : 1, (LAS char*)lds, vcu, G);
#endif
        else if (ph == 6 || ph == 10 || ph == 13 || ph == 17 || ph == 21 || ph == 24) {
            const int L = ph >= 14 ? 1 : 0; const int k = (ph == 6 || ph == 17) ? 1 : (ph == 10 || ph == 21) ? 3 : 5;
            const float* ga = gains + (L * 6 + k) * DM;
            const float* gb = (k < 5) ? gains + (L * 6 + k + 1) * DM : (L == 0 ? gains + 6 * DM : nullptr);
            phase_resnorm(P, ga, gb, vcu, NGW, ph == 6);
        } else {
            GemmDesc d; const int n = gemm_desc(ph, 0, P.ws, d);
#pragma nounroll
            for (int sub = 0; sub < n; ++sub) {
                gemm_desc(ph, sub, P.ws, d);
                pg8::Gemm g{d.A, d.Bt, d.M, d.N, d.K}; pg8::StaticOrder S; S.init(d.M, d.N, G, bx);
                pg8::EpiRt E{d.C, d.mode == 2 ? 1024 : d.N, d.act, d.mode, d.C2, d.C3};
#ifndef SKIP_GEMM
                pg8::gemm_phase<pg8::EpiRt, pg8::StaticOrder, true, true>(lds, g, S, E);
#endif
                __syncthreads();
            }
        }
#define MK_XBAR() do { XcdBarrier b_; b_.bar = (unsigned*)(P.ws + 65536); b_.x = xb_xcc_id(); b_.st = (volatile LAS unsigned*)(lds + LDS_BYTES - 16); xcd_barrier(b_); } while (0)
        if (P.ws == nullptr) grid.sync();
        if (ph + 1 < NPH_LIMIT || REPEAT_MASK != 0u) MK_XBAR();
#if EXTRA_SYNCS
        if (ph == 0) { for (int i = 0; i < EXTRA_SYNCS; ++i) MK_XBAR(); }
#endif
#if PROBE_SEL
        if (ph == 24 && blockIdx.x == 0 && threadIdx.x == 0) { const unsigned long long* pb = (const unsigned long long*)(P.ws + 4096); float v = 0.f;
            const int sel = PROBE_SEL;
            if (sel >= 1 && sel <= 8) { const int w = (sel - 1) >> 2, k = (sel - 1) & 3; v = (float)(unsigned)pb[w * 8 + k] / (float)(unsigned)pb[w * 8 + 4] * 0.01f; }
            else if (sel == 9) v = (float)(unsigned)(pb[18] - pb[16]) / (float)(unsigned)(pb[19] - pb[17]);
            else if (sel == 10) v = (float)(unsigned)(pb[19] - pb[17]) * 1e-4f;
            P.out[0] += v; }
#endif
        if (((REPEAT_MASK >> ph) & 1u) && rep == 0) rep = 1; else { rep = 0; ++ph; }
    }
}

extern "C" void kernel_launch(void* const* d_in, const int* in_sizes, int n_in, void* d_out, int out_size, void* d_ws, size_t ws_size, hipStream_t stream) {
    static int grid = 0;
    if (grid == 0) {
        if (n_in != 22 || out_size != MT * DM || ws_size < WS_END) {
            fprintf(stderr, "kernel_launch: unexpected shapes: n_in %d out %d ws %zu (need %zu)\n", n_in, out_size, ws_size, (size_t)WS_END); grid = -1; return; }
        int dev = 0, cus = 0, per_cu = 0;
        if (hipGetDevice(&dev) != hipSuccess || hipDeviceGetAttribute(&cus, hipDeviceAttributeMultiprocessorCount, dev) != hipSuccess) { fprintf(stderr, "kernel_launch: device query failed\n"); grid = -1; return; }
        if (hipFuncSetAttribute((const void*)mk_fwd, hipFuncAttributeMaxDynamicSharedMemorySize, LDS_BYTES) != hipSuccess) { fprintf(stderr, "kernel_launch: hipFuncSetAttribute failed\n"); grid = -1; return; }
        if (hipOccupancyMaxActiveBlocksPerMultiprocessor(&per_cu, (const void*)mk_fwd, 512, LDS_BYTES) != hipSuccess || per_cu < 1) { fprintf(stderr, "kernel_launch: occupancy query gave %d\n", per_cu); per_cu = 1; (void)hipGetLastError(); }
        grid = cus * per_cu;
    }
    if (grid < 0) return;
    if (hipMemsetAsync((char*)d_ws + 65536, 0, 16384, stream) != hipSuccess) { fprintf(stderr, "kernel_launch: hipMemsetAsync failed\n"); return; }
    Params p{};
    for (int i = 0; i < 22; ++i) p.in[i] = (const float*)d_in[i];
    p.out = (float*)d_out; p.ws = (unsigned char*)d_ws;
    void* args[] = {&p};
    hipError_t e = hipLaunchCooperativeKernel((const void*)mk_fwd, dim3(grid), dim3(512), args, LDS_BYTES, stream);
    if (e != hipSuccess) fprintf(stderr, "kernel_launch: cooperative launch failed: %s (grid %d)\n", hipGetErrorString(e), grid);
}
```

```cpp
#include <hip/hip_runtime.h>
#include <hip/hip_cooperative_groups.h>
#include <cstdio>
#include <cstdint>
namespace cg = cooperative_groups;
namespace pg8 {
#define PG8_LAS __attribute__((address_space(3)))
typedef unsigned short bf16_t;
typedef short bf16x8 __attribute__((ext_vector_type(8)));
typedef float f32x4 __attribute__((ext_vector_type(4)));
typedef unsigned u32x4 __attribute__((ext_vector_type(4)));
constexpr int BM = 256, BK = 64, HALF = 128, HTB = HALF * BK * 2  , STAGE_BYTES = 8 * HTB, NXCD = 8, WGM = 8;

__host__ __device__ __forceinline__ int lds_byte(int r, int c) { const int st = (r >> 4) * 2 + (c >> 5), rr = r & 15, cc = c & 31, ob = rr * 64 + cc * 2; return st * 1024 + (ob ^ (((ob >> 9) & 1) << 5)); }
__host__ __device__ __forceinline__ void stage_rc(int b, int& R, int& C) { const int st = b / 1024, sb = b % 1024, swz = sb ^ (((sb >> 9) & 1) << 5); R = (st >> 1) * 16 + swz / 64; C = (st & 1) * 32 + (swz % 64) / 2; }
__host__ __device__ __forceinline__ int perm32(int rho) { const int n = rho >> 4, i = rho & 15; return 8 * (i >> 2) + 4 * n + (i & 3); }

struct Unit { int pm, pn; };
struct Gemm { const bf16_t* A; const bf16_t* Bt; int M, N, K; };

struct StaticOrder {
    int nM, nN, nwg, G, c;
    __host__ __device__ void init(int M, int N, int G_, int c_) { nM = M / BM; nN = N / BM; nwg = nM * nN; G = G_; c = c_; }
    __host__ __device__ bool next(int i, Unit& u) const {
        const long L = (long)i * G + c; if (L >= nwg) return false;
        int wgid = (int)L; { const int q = nwg / NXCD, r = nwg % NXCD, xcd = wgid % NXCD, off = wgid / NXCD; wgid = (xcd < r ? xcd * (q + 1) : r * (q + 1) + (xcd - r) * q) + off; }
        const int nig = WGM * nN, gid = wgid / nig, fm = gid * WGM, gsz = (nM - fm) < WGM ? (nM - fm) : WGM;
        u.pm = fm + ((wgid % nig) % gsz); u.pn = (wgid % nig) / gsz; return true;
    }
    __device__ __forceinline__ void a_ready(const Unit&) const {}
    __device__ __forceinline__ void done(const Unit&) const {}
};

__device__ __forceinline__ unsigned cvt_pk_bf16(float lo, float hi) { unsigned r; asm volatile("v_cvt_pk_bf16_f32 %0, %1, %2" : "=v"(r) : "v"(lo), "v"(hi)); return r; }
typedef float f32x2 __attribute__((ext_vector_type(2)));
struct EpiRt {
    static constexpr bool PERM = true, AFTER_DRAIN = false;
    bf16_t* O; int ldc; int act; int mode; bf16_t* O2; bf16_t* O3;
    __device__ __forceinline__ void operator()(const f32x4 (&acc)[2][2][4][2], const Unit& u, int wr, int wc, int fr, int fq) const {
        const int row0 = u.pm * BM + wr * 64 + fr; const int col0 = u.pn * BM + wc * 32 + 8 * fq;
#pragma unroll
        for (int ai = 0; ai < 2; ++ai)
#pragma unroll
            for (int m = 0; m < 4; ++m) { const size_t row = (size_t)(row0 + ai * HALF + m * 16);
                bf16_t* rowp = O + row * ldc + col0;
                bf16_t* p0 = rowp; bf16_t* p1 = rowp + HALF;
                if (mode == 1) { p0 = O2 + ((size_t)u.pn * 81920 + row) * 192 + wc * 32 + 8 * fq; p1 = O3 + ((size_t)u.pn * 81920 + row) * 128 + wc * 32 + 8 * fq; }
                else if (mode == 2 && u.pn >= 4) { bf16_t* hb = u.pn >= 8 ? O3 : O2; const int h0 = 2 * (u.pn & 3);
                    p0 = hb + ((size_t)h0 * 81920 + row) * 128 + wc * 32 + 8 * fq; p1 = hb + ((size_t)(h0 + 1) * 81920 + row) * 128 + wc * 32 + 8 * fq; }
#pragma unroll
                for (int bj = 0; bj < 2; ++bj) { f32x4 v0 = acc[ai][bj][m][0], v1 = acc[ai][bj][m][1];
                    if (act) {
#pragma unroll
                        for (int e = 0; e < 4; ++e) { float a = fmaxf(v0[e], 0.f), b = fmaxf(v1[e], 0.f); v0[e] = a * a; v1[e] = b * b; } }
                    u32x4 w; w.x = cvt_pk_bf16(v0[0], v0[1]); w.y = cvt_pk_bf16(v0[2], v0[3]); w.z = cvt_pk_bf16(v1[0], v1[1]); w.w = cvt_pk_bf16(v1[2], v1[3]);
                    *(u32x4*)(bj ? p1 : p0) = w; } }
    }
};
template <class Epi, class Sched, bool ALIGN_EPI = false, bool SP2 = false>
__device__ __forceinline__ void gemm_phase(PG8_LAS unsigned char* lds, const Gemm g, const Sched& S, const Epi& E) {
    int tid_ = threadIdx.x; asm volatile("" : "+v"(tid_)); const int tid = tid_, wid = __builtin_amdgcn_readfirstlane(tid >> 6), lane = tid & 63, wr = wid >> 2, wc = wid & 3, fr = lane & 15, fq = lane >> 4;
    const int K = g.K, nt = K / BK;
    unsigned voffA[2], voffB[2];
#pragma unroll
    for (int i = 0; i < 2; ++i) { int R, C; stage_rc(tid * 16 + i * 8192, R, C); const int Rb = Epi::PERM ? ((R & ~31) + perm32(R & 31)) : R;
        voffA[i] = (unsigned)(R * K + C) * 2u; voffB[i] = (unsigned)(Rb * K + C) * 2u; }
    const size_t kstep = (size_t)(BK * 2);
    const size_t hstep = (size_t)HALF * K * 2;
    const size_t tstep = 2 * hstep;
    const unsigned ldsw = (unsigned)wid * 1024u;
    const int aoff = lds_byte(wr * 64 + fr, fq * 8), boff = lds_byte(wc * 32 + fr, fq * 8);
#define PG8_SA(b, h) (((b) * 2 + (h)) * HTB)
#define PG8_SB(b, h) ((4 + (b) * 2 + (h)) * HTB)
#define PG8_STAGE(bufoff, gbase, voff) do { _Pragma("unroll") for (int _i = 0; _i < 2; ++_i) \
        __builtin_amdgcn_global_load_lds((const unsigned*)((const char*)(gbase) + (voff)[_i]), (PG8_LAS unsigned*)(lds + (bufoff) + ldsw + _i * 8192), 16, 0, 0); } while (0)
#define PG8_LDA(dst, b, h) do { _Pragma("unroll") for (int m = 0; m < 4; ++m) _Pragma("unroll") for (int k = 0; k < 2; ++k) dst[m][k] = *(const PG8_LAS bf16x8*)(lds + PG8_SA(b, h) + aoff + m * 2048 + k * 1024); } while (0)
#define PG8_LDB(dst, b, h) do { _Pragma("unroll") for (int n = 0; n < 2; ++n) _Pragma("unroll") for (int k = 0; k < 2; ++k) dst[n][k] = *(const PG8_LAS bf16x8*)(lds + PG8_SB(b, h) + boff + n * 2048 + k * 1024); } while (0)
#define PG8_MMA(ai, bj, At, Bt) do { __builtin_amdgcn_s_setprio(1); _Pragma("unroll") for (int m = 0; m < 4; ++m) _Pragma("unroll") for (int n = 0; n < 2; ++n) _Pragma("unroll") for (int k = 0; k < 2; ++k) \
        acc[ai][bj][m][n] = __builtin_amdgcn_mfma_f32_16x16x32_bf16(Bt[n][k], At[m][k], acc[ai][bj][m][n], 0, 0, 0); __builtin_amdgcn_s_setprio(0); } while (0)
#define PG8_WAIT_V(n) asm volatile("s_waitcnt vmcnt(" #n ")" ::: "memory")
#define PG8_WAIT_L(n) asm volatile("s_waitcnt lgkmcnt(" #n ")" ::: "memory")
#define PG8_BAR __builtin_amdgcn_s_barrier()
#define PG8_SCHED __builtin_amdgcn_sched_barrier(0)
    Unit cur, nxt; int ui = 0;
    if (!S.next(0, cur)) return;
    f32x4 acc[2][2][4][2];
#pragma unroll
    for (int a = 0; a < 2; ++a)
#pragma unroll
        for (int b = 0; b < 2; ++b)
#pragma unroll
            for (int m = 0; m < 4; ++m)
#pragma unroll
                for (int n = 0; n < 2; ++n) acc[a][b][m][n] = (f32x4){0.f, 0.f, 0.f, 0.f};
    bf16x8 At[4][2], B0[2][2], B1[2][2];
    const char* cA = (const char*)g.A + (size_t)cur.pm * tstep; const char* cB = (const char*)g.Bt + (size_t)cur.pn * tstep;
    S.a_ready(cur);
    if constexpr (SP2) {
        PG8_STAGE(PG8_SB(0, 0), cB, voffB); PG8_STAGE(PG8_SB(0, 1), cB + hstep, voffB); PG8_STAGE(PG8_SA(0, 0), cA, voffA); PG8_STAGE(PG8_SA(0, 1), cA + hstep, voffA);
        if (wr == 1) PG8_BAR;
        PG8_WAIT_V(2); PG8_BAR;
        PG8_STAGE(PG8_SB(1, 0), cB + kstep, voffB); PG8_STAGE(PG8_SA(1, 0), cA + kstep, voffA); PG8_STAGE(PG8_SB(1, 1), cB + hstep + kstep, voffB);
        PG8_WAIT_V(6); PG8_BAR;
    } else {
        PG8_STAGE(PG8_SB(0, 0), cB, voffB); PG8_STAGE(PG8_SA(0, 0), cA, voffA); PG8_STAGE(PG8_SB(0, 1), cB + hstep, voffB); PG8_STAGE(PG8_SA(0, 1), cA + hstep, voffA);
        if (wr == 1) PG8_BAR;
        PG8_WAIT_V(4); PG8_BAR;
        PG8_STAGE(PG8_SB(1, 0), cB + kstep, voffB); PG8_STAGE(PG8_SA(1, 0), cA + kstep, voffA); PG8_STAGE(PG8_SB(1, 1), cB + hstep + kstep, voffB);
        PG8_WAIT_V(6); PG8_BAR;
    }
    for (;;) {
        const bool has_next = S.next(ui + 1, nxt);
        const char* nA = has_next ? (const char*)g.A + (size_t)nxt.pm * tstep : cA; const char* nB = has_next ? (const char*)g.Bt + (size_t)nxt.pn * tstep : cB;
        for (int t = 0; t < nt; t += 2) {
            const bool last = (t == nt - 2);
            const char* a1 = cA + (size_t)(t + 1) * kstep;
            const char* a2 = last ? nA : cA + (size_t)(t + 2) * kstep; const char* b2 = last ? nB : cB + (size_t)(t + 2) * kstep;
            const char* a3 = a2 + kstep; const char* b3 = b2 + kstep;
            if (last && has_next) S.a_ready(nxt);
            if constexpr (SP2) {
            PG8_LDB(B0, 0, 0); PG8_LDB(B1, 0, 1); PG8_SCHED; PG8_LDA(At, 0, 0); PG8_STAGE(PG8_SA(1, 1), a1 + hstep, voffA);
            PG8_WAIT_V(8); PG8_WAIT_L(0); PG8_BAR; PG8_MMA(0, 0, At, B0); PG8_MMA(0, 1, At, B1); PG8_BAR; PG8_SCHED;
            PG8_LDA(At, 0, 1); PG8_STAGE(PG8_SB(0, 0), b2, voffB); PG8_STAGE(PG8_SB(0, 1), b2 + hstep, voffB); PG8_STAGE(PG8_SA(0, 0), a2, voffA);
            PG8_WAIT_V(8); PG8_WAIT_L(0); PG8_BAR; PG8_MMA(1, 0, At, B0); PG8_MMA(1, 1, At, B1); PG8_BAR; PG8_SCHED;
            PG8_LDB(B0, 1, 0); PG8_LDB(B1, 1, 1); PG8_SCHED; PG8_LDA(At, 1, 0); PG8_STAGE(PG8_SA(0, 1), a2 + hstep, voffA);
            PG8_WAIT_V(8); PG8_WAIT_L(0); PG8_BAR; PG8_MMA(0, 0, At, B0); PG8_MMA(0, 1, At, B1); PG8_BAR; PG8_SCHED;
            PG8_LDA(At, 1, 1); PG8_STAGE(PG8_SB(1, 0), b3, voffB); PG8_STAGE(PG8_SB(1, 1), b3 + hstep, voffB); PG8_STAGE(PG8_SA(1, 0), a3, voffA);
            PG8_WAIT_V(8); PG8_WAIT_L(0); PG8_BAR; PG8_MMA(1, 0, At, B0); PG8_MMA(1, 1, At, B1); PG8_BAR; PG8_SCHED;
            } else {
            PG8_LDB(B0, 0, 0); PG8_SCHED; PG8_LDA(At, 0, 0); PG8_STAGE(PG8_SA(1, 1), a1 + hstep, voffA);
            PG8_WAIT_L(8); PG8_BAR; PG8_WAIT_L(0); PG8_MMA(0, 0, At, B0); PG8_BAR; PG8_SCHED;
            PG8_LDB(B1, 0, 1); PG8_STAGE(PG8_SB(0, 0), b2, voffB);
            PG8_BAR; PG8_WAIT_L(0); PG8_MMA(0, 1, At, B1); PG8_BAR;
            PG8_LDA(At, 0, 1); PG8_STAGE(PG8_SA(0, 0), a2, voffA);
            PG8_BAR; PG8_WAIT_L(0); PG8_MMA(1, 0, At, B0); PG8_BAR; PG8_SCHED;
            PG8_STAGE(PG8_SB(0, 1), b2 + hstep, voffB);
            PG8_WAIT_V(6); PG8_BAR; PG8_MMA(1, 1, At, B1); PG8_BAR;
            PG8_LDB(B0, 1, 0); PG8_SCHED; PG8_LDA(At, 1, 0); PG8_STAGE(PG8_SA(0, 1), a2 + hstep, voffA);
            PG8_WAIT_L(8); PG8_BAR; PG8_WAIT_L(0); PG8_MMA(0, 0, At, B0); PG8_BAR; PG8_SCHED;
            PG8_LDB(B1, 1, 1); PG8_STAGE(PG8_SB(1, 0), b3, voffB);
            PG8_BAR; PG8_WAIT_L(0); PG8_MMA(0, 1, At, B1); PG8_BAR;
            PG8_LDA(At, 1, 1); PG8_STAGE(PG8_SA(1, 0), a3, voffA);
            PG8_BAR; PG8_WAIT_L(0); PG8_MMA(1, 0, At, B0); PG8_BAR; PG8_SCHED;
            PG8_STAGE(PG8_SB(1, 1), b3 + hstep, voffB);
            PG8_WAIT_V(6); PG8_BAR; PG8_MMA(1, 1, At, B1); PG8_BAR;
            }
        }
        if constexpr (ALIGN_EPI) { if (wr == 0) PG8_BAR; }
        if constexpr (!Epi::AFTER_DRAIN) { E(acc, cur, wr, wc, fr, fq); S.done(cur); }
        if (!has_next) break;
#pragma unroll
        for (int a = 0; a < 2; ++a)
#pragma unroll
            for (int b = 0; b < 2; ++b)
#pragma unroll
                for (int m = 0; m < 4; ++m)
#pragma unroll
                    for (int n = 0; n < 2; ++n) acc[a][b][m][n] = (f32x4){0.f, 0.f, 0.f, 0.f};
        cur = nxt; cA = nA; cB = nB; ++ui;
        if constexpr (ALIGN_EPI) { if (wr == 1) PG8_BAR; }
    }
    PG8_WAIT_V(0);
    if constexpr (!ALIGN_EPI) { if (wr == 0) PG8_BAR; }
    PG8_BAR;
    if constexpr (Epi::AFTER_DRAIN) { E.fused(acc, cur, wr, wc, fr, fq, lds, wid, lane); S.done(cur); }
#undef PG8_SA
#undef PG8_SB
#undef PG8_STAGE
#undef PG8_LDA
#undef PG8_LDB
#undef PG8_MMA
#undef PG8_WAIT_V
#undef PG8_WAIT_L
#undef PG8_BAR
#undef PG8_SCHED
}
}

#define LAS __attribute__((address_space(3)))
typedef unsigned short bf16_t;
typedef short bf16x8 __attribute__((ext_vector_type(8)));
typedef short s16x4 __attribute__((ext_vector_type(4)));
typedef float f32x4 __attribute__((ext_vector_type(4)));
typedef float f32x16 __attribute__((ext_vector_type(16)));
typedef unsigned u32x4 __attribute__((ext_vector_type(4)));
typedef unsigned u32x2 __attribute__((ext_vector_type(2)));

#ifndef PP_BALANCED
#define PP_BALANCED 0
#endif
#ifndef EXTRA_SYNCS
#define EXTRA_SYNCS 0
#endif
#ifndef PROBE_SEL
#define PROBE_SEL 0
#endif
#ifndef REPEAT_MASK
#define REPEAT_MASK 0u
#endif
#ifndef NPH_LIMIT
#define NPH_LIMIT 25
#endif

constexpr int DM = 1024, MP = 4 * 4096, MS = 8 * 8192, MT = MP + MS;
constexpr int SP = 4096, SS = 8192;
constexpr int NMR = 12 * 256;
constexpr float EPS = 1e-6f, LOG2E = 1.4426950408889634f;
constexpr float LAMBDA_INIT = 0.35550906759f;

constexpr size_t MiB = 1u << 20;
constexpr size_t O_COS = 1 * MiB, O_SIN = 2 * MiB;
constexpr size_t O_W_MLA_IN = 3 * MiB;
constexpr size_t O_W_MLA_UQ = O_W_MLA_IN + 2 * MiB;
constexpr size_t O_W_MLA_UKV = O_W_MLA_UQ + 1 * MiB;
constexpr size_t O_W_MLA_O = O_W_MLA_UKV + 1 * MiB;
constexpr size_t O_W_DIFF_IN = O_W_MLA_O + 2 * MiB;
constexpr size_t O_W_DIFF_O = O_W_DIFF_IN + 6 * MiB;
constexpr size_t O_W_XQ = O_W_DIFF_O + 2 * MiB;
constexpr size_t O_W_XKV = O_W_XQ + 4 * MiB;
constexpr size_t O_W_XO = O_W_XKV + 8 * MiB;
constexpr size_t O_W_1 = O_W_XO + 4 * MiB;
constexpr size_t O_W_2 = O_W_1 + 16 * MiB;
constexpr size_t O_MEMN = O_W_2 + 16 * MiB;
constexpr size_t O_MKV = O_MEMN + 12 * MiB;
constexpr size_t A0 = 104 * MiB;
static_assert(O_MKV + 24 * MiB <= A0, "fixed region");
constexpr size_t O_XH = A0;
constexpr size_t O_VH = A0;
constexpr size_t O_O = A0 + 160 * MiB;
constexpr size_t O_C = O_O, O_CNQ = O_O + 120 * MiB;
constexpr size_t O_ACT = A0 + 160 * MiB;
constexpr size_t O_BR = A0 + 320 * MiB;
constexpr size_t O_Q = O_BR, O_KH = O_BR + 240 * MiB, O_CNKV = O_BR + 480 * MiB, O_XQ = O_BR;
constexpr size_t O_DQ = O_BR, O_DKH = O_BR + 160 * MiB, O_DVH = O_BR + 320 * MiB;
constexpr size_t WS_END = A0 + 880 * MiB;
static_assert(WS_END <= 1024 * MiB, "workspace");

constexpr int LDS_BYTES = 163840;

struct Params { const float* in[22]; float* out; unsigned char* ws; };

__device__ __forceinline__ unsigned cvtpk(float lo, float hi) { unsigned r; asm volatile("v_cvt_pk_bf16_f32 %0, %1, %2" : "=v"(r) : "v"(lo), "v"(hi)); return r; }
__device__ __forceinline__ int otid() { int t = threadIdx.x; asm volatile("" : "+v"(t)); return t; }
__device__ __forceinline__ bf16x8 scale_frag(bf16x8 x, float c) {
    float f[8];
#pragma unroll
    for (int e = 0; e < 8; ++e) f[e] = __uint_as_float(((unsigned)(unsigned short)x[e]) << 16) * c;
    u32x4 w = {cvtpk(f[0], f[1]), cvtpk(f[2], f[3]), cvtpk(f[4], f[5]), cvtpk(f[6], f[7])};
    return __builtin_bit_cast(bf16x8, w);
}
__device__ __forceinline__ float bflo(unsigned w) { return __uint_as_float(w << 16); }
__device__ __forceinline__ float bfhi(unsigned w) { return __uint_as_float(w & 0xffff0000u); }
__device__ __forceinline__ float bf1(short s) { return __uint_as_float(((unsigned)(unsigned short)s) << 16); }
template <int CTRL> __device__ __forceinline__ float dppx(float v) { return __int_as_float(__builtin_amdgcn_update_dpp(0, __float_as_int(v), CTRL, 0xF, 0xF, true)); }
__device__ __forceinline__ float half_sum(float v) {
    v += dppx<0xB1>(v); v += dppx<0x4E>(v); v += dppx<0x141>(v); v += dppx<0x140>(v);
    v += __int_as_float(__builtin_amdgcn_ds_swizzle(__float_as_int(v), 0x401F));
    return v;
}
__device__ __forceinline__ float wave_sum(float v) {
    v = half_sum(v);
    auto rr = __builtin_amdgcn_permlane32_swap(__float_as_uint(v), __float_as_uint(v), false, false);
    return __uint_as_float(rr[0]) + __uint_as_float(rr[1]);
}
__device__ __forceinline__ int tok_pos(int row) { return row < MP ? (row & (SP - 1)) : ((row - MP) & (SS - 1)); }

__device__ __forceinline__ void transpose_item(const float* __restrict__ W, int K, int N, bf16_t* __restrict__ WT, LAS float* scr, int item, int lane) {
    const int nblk = N / 32, kb = item / nblk, nb = item % nblk, k0 = 64 * kb, n0 = 32 * nb;
#pragma unroll 8
    for (int i = 0; i < 32; ++i) { const int kk = 2 * i + (lane >> 5); scr[kk * 33 + (lane & 31)] = W[(size_t)(k0 + kk) * N + n0 + (lane & 31)]; }
    asm volatile("s_waitcnt lgkmcnt(0)" ::: "memory");
    const int c = lane & 7;
#pragma unroll
    for (int j = 0; j < 4; ++j) { const int n = (lane >> 3) + 8 * j; const LAS float* s = scr + (8 * c) * 33 + n;
        u32x4 o; o.x = cvtpk(s[0 * 33], s[1 * 33]); o.y = cvtpk(s[2 * 33], s[3 * 33]); o.z = cvtpk(s[4 * 33], s[5 * 33]); o.w = cvtpk(s[6 * 33], s[7 * 33]);
        *(u32x4*)(WT + (size_t)(n0 + n) * K + k0 + 8 * c) = o; }
    asm volatile("s_waitcnt lgkmcnt(0)" ::: "memory");
}

__device__ __forceinline__ void norm_store_row(const f32x4 (&v)[4], const float* __restrict__ g, bf16_t* __restrict__ orow, int lane) {
    float s = 0.f;
#pragma unroll
    for (int j = 0; j < 4; ++j) s += (v[j].x * v[j].x + v[j].y * v[j].y) + (v[j].z * v[j].z + v[j].w * v[j].w);
    s = wave_sum(s);
    const float rs = 1.0f / sqrtf(s * (1.f / 1024.f) + EPS);
#pragma unroll
    for (int j = 0; j < 4; ++j) { const f32x4 gg = *(const f32x4*)(g + 4 * lane + 256 * j);
        u32x2 w; w.x = cvtpk(v[j].x * rs * gg.x, v[j].y * rs * gg.y); w.y = cvtpk(v[j].z * rs * gg.z, v[j].w * rs * gg.w);
        *(u32x2*)(orow + 4 * lane + 256 * j) = w; }
}

__device__ __forceinline__ void phase_prologue(const Params& P, LAS unsigned char* lds, int vcu, int NGW) {
    const int tid = otid(), lane = tid & 63, wave = __builtin_amdgcn_readfirstlane(tid >> 6), gw = vcu * 8 + wave;
    unsigned char* ws = P.ws;
    LAS float* scr = (LAS float*)(lds + wave * 16384);
    {
        constexpr int I0 = (1024 / 64) * (576 / 32), I1 = (256 / 64) * (1536 / 32), I2 = (256 / 64) * (2048 / 32), I3 = (1024 / 64) * (1024 / 32),
                      I4 = (1024 / 64) * (3072 / 32), I5 = I3, I6 = I3, I7 = (1024 / 64) * (2048 / 32), I8 = I3, I9 = (1024 / 64) * (4096 / 32), I10 = (4096 / 64) * (1024 / 32);
        constexpr int NIT = I0 + I1 + I2 + I3 + I4 + I5 + 2 * I6 + 2 * I7 + 2 * I8 + 2 * I9 + 2 * I10;
        for (int it = gw; it < NIT; it += NGW) {
            int r = it;
#define TJ(CNT, SRC, KK, NN, DST) if (r < (CNT)) { transpose_item((SRC), (KK), (NN), (bf16_t*)(ws + (DST)), scr, r, lane); continue; } r -= (CNT);
            TJ(I0, P.in[6], 1024, 576, O_W_MLA_IN)
            TJ(I1, P.in[9], 256, 1536, O_W_MLA_UQ)
            TJ(I2, P.in[10], 256, 2048, O_W_MLA_UKV)
            TJ(I3, P.in[11], 1024, 1024, O_W_MLA_O)
            TJ(I4, P.in[12], 1024, 3072, O_W_DIFF_IN)
            TJ(I5, P.in[15], 1024, 1024, O_W_DIFF_O)
            TJ(I6, P.in[17], 1024, 1024, O_W_XQ)
            TJ(I6, P.in[17] + 1024 * 1024, 1024, 1024, O_W_XQ + 2 * MiB)
            TJ(I7, P.in[18], 1024, 2048, O_W_XKV)
            TJ(I7, P.in[18] + 1024 * 2048, 1024, 2048, O_W_XKV + 4 * MiB)
            TJ(I8, P.in[19], 1024, 1024, O_W_XO)
            TJ(I8, P.in[19] + 1024 * 1024, 1024, 1024, O_W_XO + 2 * MiB)
            TJ(I9, P.in[20], 1024, 4096, O_W_1)
            TJ(I9, P.in[20] + 1024 * 4096, 1024, 4096, O_W_1 + 8 * MiB)
            TJ(I10, P.in[21], 4096, 1024, O_W_2)
            TJ(I10, P.in[21] + 4096 * 1024, 4096, 1024, O_W_2 + 8 * MiB)
#undef TJ
        }
    }
    {
        float* cosT = (float*)(ws + O_COS); float* sinT = (float*)(ws + O_SIN);
        for (int idx = gw * 64 + lane; idx < 8192 * 32; idx += NGW * 64) {
            const int pos = idx >> 5, i = idx & 31;
            const float fr = exp2f(-(float)i * (13.287712379549449f / 32.f));
            const float ang = (float)pos * fr;
            cosT[idx] = cosf(ang); sinT[idx] = sinf(ang);
        }
    }
    for (int r = gw; r < 2 * NMR; r += NGW) {
        const int li = r / NMR, rr = r % NMR;
        const float* src = rr < 1024 ? P.in[2] + (size_t)rr * DM : P.in[3] + (size_t)(rr - 1024) * DM;
        f32x4 v[4];
#pragma unroll
        for (int j = 0; j < 4; ++j) v[j] = *(const f32x4*)(src + 4 * lane + 256 * j);
        norm_store_row(v, P.in[16] + li * DM, (bf16_t*)(ws + O_MEMN) + (size_t)r * DM, lane);
    }
    for (int r = gw; r < MT; r += NGW) {
        const float* src = r < MP ? P.in[0] + (size_t)r * DM : P.in[1] + (size_t)(r - MP) * DM;
        f32x4 v[4];
#pragma unroll
        for (int j = 0; j < 4; ++j) v[j] = *(const f32x4*)(src + 4 * lane + 256 * j);
        norm_store_row(v, P.in[4], (bf16_t*)(ws + O_XH) + (size_t)r * DM, lane);
    }
}

__device__ __forceinline__ void phase_resnorm(const Params& P, const float* __restrict__ ga, const float* __restrict__ gb, int vcu, int NGW, bool first) {
#define XSRC(row) ((first) ? ((row) < MP ? P.in[0] + (size_t)(row) * DM : P.in[1] + (size_t)((row) - MP) * DM) : (const float*)(P.out + (size_t)(row) * DM))
    const int tid = otid(), lane = tid & 63, gw = vcu * 8 + __builtin_amdgcn_readfirstlane(tid >> 6);
    bf16_t* H = (bf16_t*)(P.ws + O_XH);
    int r = gw;
    for (; r + 3 * NGW < MT; r += 4 * NGW) {
        f32x4 h[4][4], x[4][4]; float sq[4] = {0.f, 0.f, 0.f, 0.f};
#pragma unroll
        for (int q = 0; q < 4; ++q) { const size_t oq = (size_t)(r + q * NGW) * DM + 4 * lane;
#pragma unroll
            for (int j = 0; j < 4; ++j) { const u32x2 w = *(const u32x2*)(H + oq + 256 * j);
                h[q][j] = (f32x4){bflo(w.x), bfhi(w.x), bflo(w.y), bfhi(w.y)};
                x[q][j] = __builtin_nontemporal_load((const f32x4*)(XSRC(r + q * NGW) + 4 * lane + 256 * j));
                sq[q] += (h[q][j].x * h[q][j].x + h[q][j].y * h[q][j].y) + (h[q][j].z * h[q][j].z + h[q][j].w * h[q][j].w); } }
#pragma unroll
        for (int q = 0; q < 4; ++q) { const size_t oq = (size_t)(r + q * NGW) * DM + 4 * lane;
            const float rs = 1.0f / sqrtf(wave_sum(sq[q]) * (1.f / 1024.f) + EPS);
#pragma unroll
            for (int j = 0; j < 4; ++j) { const f32x4 gg = *(const f32x4*)(ga + 4 * lane + 256 * j);
                x[q][j] = x[q][j] + h[q][j] * rs * gg;
                __builtin_nontemporal_store(x[q][j], (f32x4*)(P.out + oq + 256 * j)); }
            if (gb) norm_store_row(x[q], gb, H + (size_t)(r + q * NGW) * DM, lane); }
    }
    for (; r < MT; r += NGW) {
        f32x4 h[4], x[4]; float s = 0.f;
#pragma unroll
        for (int j = 0; j < 4; ++j) { const u32x2 w = *(const u32x2*)(H + (size_t)r * DM + 4 * lane + 256 * j);
            h[j] = (f32x4){bflo(w.x), bfhi(w.x), bflo(w.y), bfhi(w.y)};
            x[j] = *(const f32x4*)(XSRC(r) + 4 * lane + 256 * j);
            s += (h[j].x * h[j].x + h[j].y * h[j].y) + (h[j].z * h[j].z + h[j].w * h[j].w); }
        s = wave_sum(s);
        const float rs = 1.0f / sqrtf(s * (1.f / 1024.f) + EPS);
#pragma unroll
        for (int j = 0; j < 4; ++j) { const f32x4 gg = *(const f32x4*)(ga + 4 * lane + 256 * j);
            x[j] = x[j] + h[j] * rs * gg;
            *(f32x4*)(P.out + (size_t)r * DM + 4 * lane + 256 * j) = x[j]; }
        if (gb) norm_store_row(x, gb, H + (size_t)r * DM, lane);
    }
}

#undef XSRC
__device__ __forceinline__ void phase_cnorm(const Params& P, int vcu, int NGW) {
    const int tid = otid(), lane = tid & 63, gw = vcu * 8 + __builtin_amdgcn_readfirstlane(tid >> 6);
    const bf16_t* C = (const bf16_t*)(P.ws + O_C);
    bf16_t* CNQ = (bf16_t*)(P.ws + O_CNQ); bf16_t* CNKV = (bf16_t*)(P.ws + O_CNKV); bf16_t* KH = (bf16_t*)(P.ws + O_KH);
    const float* cosT = (const float*)(P.ws + O_COS); const float* sinT = (const float*)(P.ws + O_SIN);
    const f32x4 gq = *(const f32x4*)(P.in[7] + 4 * lane), gk = *(const f32x4*)(P.in[8] + 4 * lane);
    for (int r = gw; r < MT; r += NGW) {
        const bf16_t* c = C + (size_t)r * 768;
        const u32x2 a = *(const u32x2*)(c + 4 * lane), b = *(const u32x2*)(c + 256 + 4 * lane);
        const float kr = __uint_as_float(((unsigned)c[512 + lane]) << 16);
        const f32x4 va = {bflo(a.x), bfhi(a.x), bflo(a.y), bfhi(a.y)}, vb = {bflo(b.x), bfhi(b.x), bflo(b.y), bfhi(b.y)};
        float sa = (va.x * va.x + va.y * va.y) + (va.z * va.z + va.w * va.w), sb = (vb.x * vb.x + vb.y * vb.y) + (vb.z * vb.z + vb.w * vb.w);
        sa = wave_sum(sa); sb = wave_sum(sb);
        const float ra = 1.0f / sqrtf(sa * (1.f / 256.f) + EPS), rb = 1.0f / sqrtf(sb * (1.f / 256.f) + EPS);
        u32x2 wa, wb;
        wa.x = cvtpk(va.x * ra * gq.x, va.y * ra * gq.y); wa.y = cvtpk(va.z * ra * gq.z, va.w * ra * gq.w);
        wb.x = cvtpk(vb.x * rb * gk.x, vb.y * rb * gk.y); wb.y = cvtpk(vb.z * rb * gk.z, vb.w * rb * gk.w);
        *(u32x2*)(CNQ + (size_t)r * 256 + 4 * lane) = wa;
        *(u32x2*)(CNKV + (size_t)r * 256 + 4 * lane) = wb;
        const int pos = tok_pos(r), i = lane & 31;
        const float cs = cosT[pos * 32 + i], sn = sinT[pos * 32 + i];
        float pr; { auto rr = __builtin_amdgcn_permlane32_swap(__float_as_uint(kr), __float_as_uint(kr), false, false); pr = __uint_as_float(lane < 32 ? rr[1] : rr[0]); }
        const float o = lane < 32 ? kr * cs - pr * sn : pr * sn + kr * cs;
        const bf16_t ob = (bf16_t)(cvtpk(o, 0.f) & 0xffffu);
#pragma unroll
        for (int h = 0; h < 8; ++h) KH[((size_t)h * MT + r) * 192 + 128 + lane] = ob;
    }
}

namespace att {
constexpr int LDS_V = 0, LDS_K = 16384, LDS_WS = 49152, LDS_TAB = 51200, LDS_STASH = 53248;
__device__ __forceinline__ int crow(int r, int hi) { return (r & 3) + 8 * (r >> 2) + 4 * hi; }
#define SBAR() __builtin_amdgcn_sched_barrier(0)
__device__ __forceinline__ int v_st(int k, int c) { const int kk = (k & ~0xC) | ((k & 4) << 1) | ((k & 8) >> 1); return ((kk >> 3) * 4 + (c >> 5)) * 512 + ((kk & 7) * 32 + (c & 31)) * 2; }
__device__ __forceinline__ int v_rd_base(int lane) { return ((lane & 3) << 3) | (((lane >> 2) & 3) << 6) | (((lane >> 4) & 1) << 5) | (((lane >> 5) & 1) << 8); }
constexpr int v_rd_off(int d0, int ks, int half) { return d0 * 512 + ks * 4096 + half * 2048; }
template <int OFF> __device__ __forceinline__ s16x4 tr_read(int vb) {
    s16x4 r; asm volatile("ds_read_b64_tr_b16 %0, %1 offset:%2" : "=&v"(r) : "v"(vb), "i"(OFF) : "memory"); return r;
}
template <int D0> __device__ __forceinline__ void pv_one(f32x16& od, int vb, bf16x8 pa0, bf16x8 pa1, bf16x8 pa2, bf16x8 pa3) {
    const s16x4 l0 = tr_read<v_rd_off(D0, 0, 0)>(vb), h0 = tr_read<v_rd_off(D0, 0, 1)>(vb), l1 = tr_read<v_rd_off(D0, 1, 0)>(vb), h1 = tr_read<v_rd_off(D0, 1, 1)>(vb);
    const s16x4 l2 = tr_read<v_rd_off(D0, 2, 0)>(vb), h2 = tr_read<v_rd_off(D0, 2, 1)>(vb), l3 = tr_read<v_rd_off(D0, 3, 0)>(vb), h3 = tr_read<v_rd_off(D0, 3, 1)>(vb);
    asm volatile("s_waitcnt lgkmcnt(0)" ::: "memory"); SBAR();
#define PK(L, H) (bf16x8){L[0], L[1], L[2], L[3], H[0], H[1], H[2], H[3]}
    od = __builtin_amdgcn_mfma_f32_32x32x16_bf16(pa0, PK(l0, h0), od, 0, 0, 0);
    od = __builtin_amdgcn_mfma_f32_32x32x16_bf16(pa1, PK(l1, h1), od, 0, 0, 0);
    od = __builtin_amdgcn_mfma_f32_32x32x16_bf16(pa2, PK(l2, h2), od, 0, 0, 0);
    od = __builtin_amdgcn_mfma_f32_32x32x16_bf16(pa3, PK(l3, h3), od, 0, 0, 0);
#undef PK
}

template <int D0> __device__ __forceinline__ void pv_rd(s16x4 (&l)[4], s16x4 (&h)[4], int vb) {
    l[0] = tr_read<v_rd_off(D0, 0, 0)>(vb); h[0] = tr_read<v_rd_off(D0, 0, 1)>(vb); l[1] = tr_read<v_rd_off(D0, 1, 0)>(vb); h[1] = tr_read<v_rd_off(D0, 1, 1)>(vb);
    l[2] = tr_read<v_rd_off(D0, 2, 0)>(vb); h[2] = tr_read<v_rd_off(D0, 2, 1)>(vb); l[3] = tr_read<v_rd_off(D0, 3, 0)>(vb); h[3] = tr_read<v_rd_off(D0, 3, 1)>(vb);
}
__device__ __forceinline__ void pv_mm(f32x16& od, const s16x4 (&l)[4], const s16x4 (&h)[4], bf16x8 pa0, bf16x8 pa1, bf16x8 pa2, bf16x8 pa3) {
#define PK(L, H) (bf16x8){L[0], L[1], L[2], L[3], H[0], H[1], H[2], H[3]}
    od = __builtin_amdgcn_mfma_f32_32x32x16_bf16(pa0, PK(l[0], h[0]), od, 0, 0, 0);
    od = __builtin_amdgcn_mfma_f32_32x32x16_bf16(pa1, PK(l[1], h[1]), od, 0, 0, 0);
    od = __builtin_amdgcn_mfma_f32_32x32x16_bf16(pa2, PK(l[2], h[2]), od, 0, 0, 0);
    od = __builtin_amdgcn_mfma_f32_32x32x16_bf16(pa3, PK(l[3], h[3]), od, 0, 0, 0);
#undef PK
}
template <int B0> __device__ __forceinline__ void pv_half(f32x16 (&o)[4], int vb, bf16x8 pa0, bf16x8 pa1, bf16x8 pa2, bf16x8 pa3) {
    s16x4 la[4], ha[4], lb[4], hb[4];
    asm volatile("s_waitcnt lgkmcnt(0)" ::: "memory");
    pv_rd<B0>(la, ha, vb); pv_rd<B0 + 1>(lb, hb, vb);
    asm volatile("s_waitcnt lgkmcnt(8)" ::: "memory"); SBAR(); pv_mm(o[B0], la, ha, pa0, pa1, pa2, pa3); SBAR();
    asm volatile("s_waitcnt lgkmcnt(0)" ::: "memory"); SBAR(); pv_mm(o[B0 + 1], lb, hb, pa0, pa1, pa2, pa3); SBAR();
}
__device__ __forceinline__ void pv_all(f32x16 (&o)[4], int vb, bf16x8 pa0, bf16x8 pa1, bf16x8 pa2, bf16x8 pa3) {
    s16x4 la[4], ha[4], lb[4], hb[4];
    asm volatile("s_waitcnt lgkmcnt(0)" ::: "memory");
    pv_rd<0>(la, ha, vb); pv_rd<1>(lb, hb, vb);
    asm volatile("s_waitcnt lgkmcnt(8)" ::: "memory"); SBAR(); pv_mm(o[0], la, ha, pa0, pa1, pa2, pa3); SBAR();
    pv_rd<2>(la, ha, vb);
    asm volatile("s_waitcnt lgkmcnt(8)" ::: "memory"); SBAR(); pv_mm(o[1], lb, hb, pa0, pa1, pa2, pa3); SBAR();
    pv_rd<3>(lb, hb, vb);
    asm volatile("s_waitcnt lgkmcnt(8)" ::: "memory"); SBAR(); pv_mm(o[2], la, ha, pa0, pa1, pa2, pa3); SBAR();
    asm volatile("s_waitcnt lgkmcnt(0)" ::: "memory"); SBAR(); pv_mm(o[3], lb, hb, pa0, pa1, pa2, pa3); SBAR();
}

template <int DQK, bool MLAK, bool BIAS, bool PREFETCH>
__device__ __forceinline__ void attn_core(f32x16 (&o)[4], const bf16x8 (&qr)[DQK / 16],
                                          const bf16_t* __restrict__ Kg, int ldk, const bf16_t* __restrict__ K2g, const bf16_t* __restrict__ Vg, int ldv,
                                          int nkeys, float C, int qw0, LAS char* lds) {
    constexpr int PITCH = DQK * 2, CPR = DQK / 8, NKCH = DQK / 64;
    const int tid = otid(), wid = tid >> 6, lane = tid & 63, r32 = lane & 31, hi = lane >> 5;
    LAS char* V_lds = lds + LDS_V; LAS char* K_lds = lds + LDS_K;
    LAS float* wsf = (LAS float*)(lds + LDS_WS) + wid * 64; LAS float* li_l = wsf; LAS float* al_l = wsf + 32;
    const LAS float* tab = (const LAS float*)(lds + LDS_TAB);
    const int sr = tid >> 4, sc = (tid & 15) * 8, vst0 = v_st(sr, sc), vst1 = v_st(32 + sr, sc);
    const unsigned voff0 = (unsigned)(sr * ldv + sc), voff1 = (unsigned)((32 + sr) * ldv + sc);
    unsigned koff[NKCH]; int kdst[NKCH];
#pragma unroll
    for (int c = 0; c < NKCH; ++c) {
        int row, col;
        if (MLAK) { if (c < 2) { row = sr + 32 * c; col = sc; } else { row = tid >> 3; col = 128 + (tid & 7) * 8; } }
        else { const int id = tid + 512 * c; row = id / CPR; col = (id % CPR) * 8; }
        koff[c] = (MLAK && c == 2) ? (unsigned)(row * 64 + (col - 128)) : (unsigned)(row * ldk + col);
        kdst[c] = row * PITCH + ((col * 2) ^ ((row & 7) << 4)); }
    const int vb0 = (int)(unsigned)(uintptr_t)V_lds + v_rd_base(lane);
    const int kro = r32 * PITCH, kx = (r32 & 7) << 4;
    float m_reg = -1e30f, l_reg = 0.f;
#pragma unroll
    for (int d = 0; d < 4; ++d) o[d] = f32x16{};
    const int NT = nkeys / 64;
    bf16x8 vs0, vs1, ks[NKCH];
#define ATT_LOAD(t) do { const bf16_t* vt_ = Vg + (size_t)(t) * 64 * ldv; const bf16_t* kt_ = Kg + (size_t)(t) * 64 * ldk; const bf16_t* k2t_ = K2g + (size_t)(t) * 64 * 64; \
        vs0 = *(const bf16x8*)(vt_ + voff0); vs1 = *(const bf16x8*)(vt_ + voff1); \
        _Pragma("unroll") for (int c = 0; c < NKCH; ++c) ks[c] = *(const bf16x8*)(((MLAK && c == 2) ? k2t_ : kt_) + koff[c]); } while (0)
    if (PREFETCH) ATT_LOAD(0);
#pragma nounroll
    for (int j = 0; j < NT; ++j) {
        __syncthreads();
        if (!PREFETCH) ATT_LOAD(j);
        *(LAS bf16x8*)(V_lds + vst0) = vs0; *(LAS bf16x8*)(V_lds + vst1) = vs1;
#pragma unroll
        for (int c = 0; c < NKCH; ++c) *(LAS bf16x8*)(K_lds + kdst[c]) = ks[c];
        __syncthreads();
        if (PREFETCH && j + 1 < NT) ATT_LOAD(j + 1);
        f32x16 p0 = f32x16{}, p1 = f32x16{};
#pragma unroll
        for (int d0 = 0; d0 < DQK / 16; ++d0) { const int cb = ((d0 * 16 + hi * 8) * 2) ^ kx;
            const bf16x8 b0 = *(const LAS bf16x8*)(K_lds + kro + cb);
            const bf16x8 b1 = *(const LAS bf16x8*)(K_lds + kro + 32 * PITCH + cb);
            p0 = __builtin_amdgcn_mfma_f32_32x32x16_bf16(b0, qr[d0], p0, 0, 0, 0);
            p1 = __builtin_amdgcn_mfma_f32_32x32x16_bf16(b1, qr[d0], p1, 0, 0, 0); }
        if constexpr (BIAS) {
            const int kq = j * 64 - qw0;
            if (kq + 63 <= -128) { const float b = tab[0];
#pragma unroll
                for (int r = 0; r < 16; ++r) { p0[r] = fmaf(p0[r], C, b); p1[r] = fmaf(p1[r], C, b); } }
            else if (kq - 31 >= 128) { const float b = tab[256];
#pragma unroll
                for (int r = 0; r < 16; ++r) { p0[r] = fmaf(p0[r], C, b); p1[r] = fmaf(p1[r], C, b); } }
            else {
#pragma unroll
                for (int r = 0; r < 16; ++r) { const int i0 = kq + crow(r, hi) - r32 + 128;
                    const int a0 = min(max(i0, 0), 256), a1 = min(max(i0 + 32, 0), 256);
                    p0[r] = fmaf(p0[r], C, tab[a0]); p1[r] = fmaf(p1[r], C, tab[a1]); } }
        } else {
#pragma unroll
            for (int r = 0; r < 16; ++r) { p0[r] *= C; p1[r] *= C; }
        }
        float pmax = p0[0];
#pragma unroll
        for (int r = 1; r < 16; ++r) pmax = fmaxf(pmax, p0[r]);
#pragma unroll
        for (int r = 0; r < 16; ++r) pmax = fmaxf(pmax, p1[r]);
        { auto rr = __builtin_amdgcn_permlane32_swap(__float_as_uint(pmax), __float_as_uint(pmax), false, false);
          pmax = fmaxf(__uint_as_float(rr[0]), __uint_as_float(rr[1])); }
        const float mn = fmaxf(m_reg, pmax);
        const float alpha = __builtin_amdgcn_exp2f(m_reg - mn); m_reg = mn;
        float ps = 0.f;
#pragma unroll
        for (int r = 0; r < 16; ++r) { p0[r] = __builtin_amdgcn_exp2f(p0[r] - mn); p1[r] = __builtin_amdgcn_exp2f(p1[r] - mn); ps += p0[r] + p1[r]; }
        { auto rr = __builtin_amdgcn_permlane32_swap(__float_as_uint(ps), __float_as_uint(ps), false, false);
          ps = __uint_as_float(rr[0]) + __uint_as_float(rr[1]); }
        l_reg = l_reg * alpha + ps;
        if (__any(alpha < 1.f)) {
            if (hi == 0) al_l[r32] = alpha;
            asm volatile("s_waitcnt lgkmcnt(0)" ::: "memory");
#pragma unroll
            for (int r = 0; r < 16; ++r) { const float a = al_l[crow(r, hi)];
#pragma unroll
                for (int d = 0; d < 4; ++d) o[d][r] *= a; }
        }
        bf16x8 pa0, pa1, pa2, pa3;
#define PK4(P, BASE, OUT) do { unsigned a0 = cvtpk(P[BASE + 0], P[BASE + 1]), a1 = cvtpk(P[BASE + 2], P[BASE + 3]);   \
    unsigned b0 = cvtpk(P[BASE + 4], P[BASE + 5]), b1 = cvtpk(P[BASE + 6], P[BASE + 7]);                              \
    auto r0 = __builtin_amdgcn_permlane32_swap(a0, b0, false, false); auto r1 = __builtin_amdgcn_permlane32_swap(a1, b1, false, false); \
    u32x4 w = {r0[0], r1[0], r0[1], r1[1]}; OUT = *reinterpret_cast<bf16x8*>(&w); } while (0)
        PK4(p0, 0, pa0); PK4(p0, 8, pa1); PK4(p1, 0, pa2); PK4(p1, 8, pa3);
#undef PK4
        SBAR();
        pv_one<0>(o[0], vb0, pa0, pa1, pa2, pa3); pv_one<1>(o[1], vb0, pa0, pa1, pa2, pa3); pv_one<2>(o[2], vb0, pa0, pa1, pa2, pa3); pv_one<3>(o[3], vb0, pa0, pa1, pa2, pa3);
    }
    if (hi == 0) li_l[r32] = l_reg;
    asm volatile("s_waitcnt lgkmcnt(0)" ::: "memory");
#pragma unroll
    for (int r = 0; r < 16; ++r) { const float rl = 1.0f / li_l[crow(r, hi)];
#pragma unroll
        for (int d = 0; d < 4; ++d) o[d][r] *= rl; }
#undef ATT_LOAD
}

template <int DQK, bool MLAK, bool BIAS>
__device__ __forceinline__ void attn_core_pp(f32x16 (&o)[4], const bf16x8 (&qr)[DQK / 16],
                                             const bf16_t* __restrict__ Kg, int ldk, const bf16_t* __restrict__ K2g, const bf16_t* __restrict__ Vg, int ldv,
                                             int nkeys, float C, int qw0, LAS char* lds, unsigned long long* prb = nullptr) {
    constexpr int PITCH = DQK * 2, KB = 64 * PITCH, CPR = DQK / 8, NKCH = DQK / 64;
    constexpr int L_V = 0, L_K = 49152, L_WS = L_K + 2 * KB, L_TAB = L_WS + 2048;
    const int tid = otid(), wid = tid >> 6, lane = tid & 63, r32 = lane & 31, hi = lane >> 5;
    const int grp = __builtin_amdgcn_readfirstlane(wid >> 2);
    LAS char* V_lds = lds + L_V; LAS char* K_lds = lds + L_K;
    LAS float* wsf = (LAS float*)(lds + L_WS) + wid * 64; LAS float* li_l = wsf; LAS float* al_l = wsf + 32;
    const LAS float* tab = (const LAS float*)(lds + L_TAB);
    const int sr = tid >> 4, sc = (tid & 15) * 8, vst0 = v_st(sr, sc), vst1 = v_st(32 + sr, sc);
    const unsigned voff0 = (unsigned)(sr * ldv + sc), voff1 = (unsigned)((32 + sr) * ldv + sc);
    unsigned koff[NKCH]; int kdst[NKCH];
#pragma unroll
    for (int c = 0; c < NKCH; ++c) {
        int row, col;
        if (MLAK) { if (c < 2) { row = sr + 32 * c; col = sc; } else { row = tid >> 3; col = 128 + (tid & 7) * 8; } }
        else { const int id = tid + 512 * c; row = id / CPR; col = (id % CPR) * 8; }
        koff[c] = (MLAK && c == 2) ? (unsigned)(row * 64 + (col - 128)) : (unsigned)(row * ldk + col);
        kdst[c] = row * PITCH + ((col * 2) ^ (((row >> 1) & 7) << 4)); }
    const int vb0 = (int)(unsigned)(uintptr_t)V_lds + v_rd_base(lane);
    const int kro = r32 * PITCH, kx = ((r32 >> 1) & 7) << 4;
    float m_reg = -1e30f, l_reg = 0.f;
#pragma unroll
    for (int d = 0; d < 4; ++d) o[d] = f32x16{};
    const int NT = nkeys / 64;
    bf16x8 vs0, vs1, ks[NKCH];
    f32x16 p0 = f32x16{}, p1 = f32x16{};
    bf16x8 pa0 = bf16x8{}, pa1 = bf16x8{}, pa2 = bf16x8{}, pa3 = bf16x8{};
#define PP_LOAD(t) do { const bf16_t* vt_ = Vg + (size_t)(t) * 64 * ldv; const bf16_t* kt_ = Kg + (size_t)(t) * 64 * ldk; const bf16_t* k2t_ = K2g + (size_t)(t) * 64 * 64; \
        vs0 = *(const bf16x8*)(vt_ + voff0); vs1 = *(const bf16x8*)(vt_ + voff1); \
        _Pragma("unroll") for (int c = 0; c < NKCH; ++c) ks[c] = *(const bf16x8*)(((MLAK && c == 2) ? k2t_ : kt_) + koff[c]); } while (0)
#define PP_WRITE(t) do { LAS char* vd_ = V_lds + ((t) % 3) * 16384; LAS char* kd_ = K_lds + ((t) & 1) * KB; \
        *(LAS bf16x8*)(vd_ + vst0) = vs0; *(LAS bf16x8*)(vd_ + vst1) = vs1; \
        _Pragma("unroll") for (int c = 0; c < NKCH; ++c) *(LAS bf16x8*)(kd_ + kdst[c]) = ks[c]; } while (0)
#define PP_KRD(dst, d0_) do { const int cb_ = (((d0_) * 16 + hi * 8) * 2) ^ kx; dst[0] = *(const LAS bf16x8*)(kb_ + cb_); dst[1] = *(const LAS bf16x8*)(kb_ + 32 * PITCH + cb_); } while (0)
#if PROBE_SEL
#define PP_QK(t) do { const LAS char* kb_ = K_lds + ((t) & 1) * KB + kro; p0 = f32x16{}; p1 = f32x16{}; \
        bf16x8 kfa[2], kfb[2]; PP_KRD(kfa, 0); \
        _Pragma("unroll") for (int d0 = 0; d0 < DQK / 16; ++d0) { \
            if (d0 + 1 < DQK / 16) { if (d0 % 2 == 0) PP_KRD(kfb, d0 + 1); else PP_KRD(kfa, d0 + 1); } \
            SBAR(); \
            if (d0 % 2 == 0) { p0 = __builtin_amdgcn_mfma_f32_32x32x16_bf16(kfa[0], qr[d0], p0, 0, 0, 0); p1 = __builtin_amdgcn_mfma_f32_32x32x16_bf16(kfa[1], qr[d0], p1, 0, 0, 0); } \
            else { p0 = __builtin_amdgcn_mfma_f32_32x32x16_bf16(kfb[0], qr[d0], p0, 0, 0, 0); p1 = __builtin_amdgcn_mfma_f32_32x32x16_bf16(kfb[1], qr[d0], p1, 0, 0, 0); } \
            SBAR(); } } while (0)
#else
#define PP_QK(t) do { const LAS char* kb_ = K_lds + ((t) & 1) * KB + kro; p0 = f32x16{}; p1 = f32x16{}; \
        bf16x8 kfa[2], kfb[2], kfc[2]; PP_KRD(kfa, 0); PP_KRD(kfb, 1); \
        _Pragma("unroll") for (int d0 = 0; d0 < DQK / 16; ++d0) { \
            if (d0 + 2 < DQK / 16) { if (d0 % 3 == 0) PP_KRD(kfc, d0 + 2); else if (d0 % 3 == 1) PP_KRD(kfa, d0 + 2); else PP_KRD(kfb, d0 + 2); } \
            SBAR(); \
            if (d0 % 3 == 0) { p0 = __builtin_amdgcn_mfma_f32_32x32x16_bf16(kfa[0], qr[d0], p0, 0, 0, 0); p1 = __builtin_amdgcn_mfma_f32_32x32x16_bf16(kfa[1], qr[d0], p1, 0, 0, 0); } \
            else if (d0 % 3 == 1) { p0 = __builtin_amdgcn_mfma_f32_32x32x16_bf16(kfb[0], qr[d0], p0, 0, 0, 0); p1 = __builtin_amdgcn_mfma_f32_32x32x16_bf16(kfb[1], qr[d0], p1, 0, 0, 0); } \
            else { p0 = __builtin_amdgcn_mfma_f32_32x32x16_bf16(kfc[0], qr[d0], p0, 0, 0, 0); p1 = __builtin_amdgcn_mfma_f32_32x32x16_bf16(kfc[1], qr[d0], p1, 0, 0, 0); } \
            SBAR(); } } while (0)
#endif
#define PK4(P, BASE, OUT) do { unsigned a0 = cvtpk(P[BASE + 0], P[BASE + 1]), a1 = cvtpk(P[BASE + 2], P[BASE + 3]);   \
    unsigned b0 = cvtpk(P[BASE + 4], P[BASE + 5]), b1 = cvtpk(P[BASE + 6], P[BASE + 7]);                              \
    auto r0 = __builtin_amdgcn_permlane32_swap(a0, b0, false, false); auto r1 = __builtin_amdgcn_permlane32_swap(a1, b1, false, false); \
    u32x4 w = {r0[0], r1[0], r0[1], r1[1]}; OUT = *reinterpret_cast<bf16x8*>(&w); } while (0)
#define PP_SMPV(t) do { \
        float pmax; \
        if constexpr (BIAS) { const int kq = (t) * 64 - qw0; \
            if (kq + 63 <= -128) { const float b = tab[0]; _Pragma("unroll") for (int r = 0; r < 16; ++r) { p0[r] = fmaf(p0[r], C, b); p1[r] = fmaf(p1[r], C, b); } } \
            else if (kq - 31 >= 128) { const float b = tab[256]; _Pragma("unroll") for (int r = 0; r < 16; ++r) { p0[r] = fmaf(p0[r], C, b); p1[r] = fmaf(p1[r], C, b); } } \
            else { _Pragma("unroll") for (int r = 0; r < 16; ++r) { const int i0 = kq + crow(r, hi) - r32 + 128; const int a0 = min(max(i0, 0), 256), a1 = min(max(i0 + 32, 0), 256); \
                    p0[r] = fmaf(p0[r], C, tab[a0]); p1[r] = fmaf(p1[r], C, tab[a1]); } } } \
        pmax = fmaxf(p0[0], p1[0]); \
        _Pragma("unroll") for (int r = 1; r < 16; ++r) pmax = fmaxf(fmaxf(pmax, p0[r]), p1[r]); \
        { auto rr = __builtin_amdgcn_permlane32_swap(__float_as_uint(pmax), __float_as_uint(pmax), false, false); pmax = fmaxf(__uint_as_float(rr[0]), __uint_as_float(rr[1])); } \
        if constexpr (!BIAS) pmax *= C; \
        const float mn = fmaxf(m_reg, pmax); const float alpha = __builtin_amdgcn_exp2f(m_reg - mn); m_reg = mn; \
        float ps = 0.f; \
        if constexpr (BIAS) { _Pragma("unroll") for (int r = 0; r < 16; ++r) { p0[r] = __builtin_amdgcn_exp2f(p0[r] - mn); p1[r] = __builtin_amdgcn_exp2f(p1[r] - mn); ps += p0[r] + p1[r]; } } \
        else { _Pragma("unroll") for (int r = 0; r < 16; ++r) { p0[r] = __builtin_amdgcn_exp2f(fmaf(p0[r], C, -mn)); p1[r] = __builtin_amdgcn_exp2f(fmaf(p1[r], C, -mn)); ps += p0[r] + p1[r]; } } \
        { auto rr = __builtin_amdgcn_permlane32_swap(__float_as_uint(ps), __float_as_uint(ps), false, false); ps = __uint_as_float(rr[0]) + __uint_as_float(rr[1]); } \
        l_reg = l_reg * alpha + ps; \
        if (__any(alpha < 1.f)) { if (hi == 0) al_l[r32] = alpha; asm volatile("s_waitcnt lgkmcnt(0)" ::: "memory"); \
            _Pragma("unroll") for (int r = 0; r < 16; ++r) { const float a = al_l[crow(r, hi)]; _Pragma("unroll") for (int d = 0; d < 4; ++d) o[d][r] *= a; } } \
        PK4(p0, 0, pa0); PK4(p0, 8, pa1); PK4(p1, 0, pa2); PK4(p1, 8, pa3); SBAR(); \
        if (PP_BALANCED) pv_half<0>(o, vb0 + ((t) % 3) * 16384, pa0, pa1, pa2, pa3); else pv_all(o, vb0 + ((t) % 3) * 16384, pa0, pa1, pa2, pa3); } while (0)
    PP_LOAD(0);
    __syncthreads();
    PP_WRITE(0);
    if (NT > 1) PP_LOAD(1);
    __syncthreads();
#define PP_BAR() do { SBAR(); asm volatile("s_waitcnt lgkmcnt(0)\n\ts_barrier" ::: "memory"); SBAR(); } while (0)
    if (grp == 1) PP_BAR();
#if PROBE_SEL
    LAS unsigned* cnt = (LAS unsigned*)(lds + L_TAB) + wid * 4;
    { unsigned z_ = 0; asm volatile("" : "+v"(z_)); if (lane < 4) cnt[lane] = z_; }
#define PT() ((unsigned)__builtin_amdgcn_readfirstlane((int)(unsigned)__builtin_readcyclecounter()))
#endif
#pragma nounroll
    for (int j = 0; j < NT; ++j) {
#if PROBE_SEL
        const unsigned t0 = PT();
#endif
        if (j + 1 < NT) { PP_WRITE(j + 1); if (j + 2 < NT) PP_LOAD(j + 2); }
        SBAR();
        if (PP_BALANCED && j > 0) pv_half<2>(o, vb0 + ((j - 1) % 3) * 16384, pa0, pa1, pa2, pa3);
        PP_QK(j);
#if PROBE_SEL
        SBAR(); const unsigned t1 = PT(); SBAR();
#endif
        PP_BAR();
#if PROBE_SEL
        SBAR(); const unsigned t2 = PT(); SBAR();
#endif
        PP_SMPV(j);
#if PROBE_SEL
        SBAR(); const unsigned t3 = PT(); SBAR();
#endif
        PP_BAR();
#if PROBE_SEL
        SBAR(); const unsigned t4 = PT(); SBAR();
        if (lane == 0) { cnt[0] += t1 - t0; cnt[1] += t2 - t1; cnt[2] += t3 - t2; cnt[3] += t4 - t3; }
#endif
    }
#if PROBE_SEL
    if (prb && lane == 0) { prb[0] += (unsigned long long)cnt[0]; prb[1] += (unsigned long long)cnt[1]; prb[2] += (unsigned long long)cnt[2]; prb[3] += (unsigned long long)cnt[3]; prb[4] += (unsigned long long)NT; }
#endif
    if (PP_BALANCED) pv_half<2>(o, vb0 + ((NT - 1) % 3) * 16384, pa0, pa1, pa2, pa3);
    if (grp == 0) PP_BAR();
#undef PP_BAR
    if (hi == 0) li_l[r32] = l_reg;
    asm volatile("s_waitcnt lgkmcnt(0)" ::: "memory");
#pragma unroll
    for (int r = 0; r < 16; ++r) { const float rl = 1.0f / li_l[crow(r, hi)];
#pragma unroll
        for (int d = 0; d < 4; ++d) o[d][r] *= rl; }
#undef PP_LOAD
#undef PP_WRITE
#undef PP_QK
#undef PP_KRD
#undef PK4
#undef PP_SMPV
}

template <int DQK, bool MLAK, bool BIAS>
__device__ __forceinline__ void attn_core_sp(f32x16 (&o)[4], const bf16x8 (&qr)[DQK / 16],
                                             const bf16_t* __restrict__ Kg, int ldk, const bf16_t* __restrict__ K2g, const bf16_t* __restrict__ Vg, int ldv,
                                             int nkeys, float C, int qw0, LAS char* lds) {
    constexpr int PITCH = DQK * 2, KBY = 64 * PITCH, CPR = DQK / 8, NKCH = DQK / 64, ND0 = DQK / 16;
    constexpr int L_V = 0, L_K = 32768, L_WS = L_K + 2 * KBY, L_TAB = L_WS + 2048;
    const int tid = otid(), wid = tid >> 6, lane = tid & 63, r32 = lane & 31, hi = lane >> 5;
    LAS char* V_lds = lds + L_V; LAS char* K_lds = lds + L_K;
    LAS float* wsf = (LAS float*)(lds + L_WS) + wid * 64; LAS float* li_l = wsf; LAS float* al_l = wsf + 32;
    const LAS float* tab = (const LAS float*)(lds + L_TAB);
    const int sr = tid >> 4, sc = (tid & 15) * 8, vst0 = v_st(sr, sc), vst1 = v_st(32 + sr, sc);
    const unsigned voff0 = (unsigned)(sr * ldv + sc), voff1 = (unsigned)((32 + sr) * ldv + sc);
    unsigned koff[NKCH]; int kdst[NKCH];
#pragma unroll
    for (int c = 0; c < NKCH; ++c) {
        int row, col;
        if (MLAK) { if (c < 2) { row = sr + 32 * c; col = sc; } else { row = tid >> 3; col = 128 + (tid & 7) * 8; } }
        else { const int id = tid + 512 * c; row = id / CPR; col = (id % CPR) * 8; }
        koff[c] = (MLAK && c == 2) ? (unsigned)(row * 64 + (col - 128)) : (unsigned)(row * ldk + col);
        kdst[c] = row * PITCH + ((col * 2) ^ (((row >> 1) & 7) << 4)); }
    const int vb0 = (int)(unsigned)(uintptr_t)V_lds + v_rd_base(lane);
    const int kro = r32 * PITCH, kx = ((r32 >> 1) & 7) << 4;
    float m_reg = -1e30f, l_reg = 0.f;
#pragma unroll
    for (int d = 0; d < 4; ++d) o[d] = f32x16{};
    const int NT = nkeys / 64;
    bf16x8 vs0, vs1, ks[NKCH];
#define SP_LOAD(t) do { const bf16_t* vt_ = Vg + (size_t)(t) * 64 * ldv; const bf16_t* kt_ = Kg + (size_t)(t) * 64 * ldk; const bf16_t* k2t_ = K2g + (size_t)(t) * 64 * 64; \
        vs0 = *(const bf16x8*)(vt_ + voff0); vs1 = *(const bf16x8*)(vt_ + voff1); \
        _Pragma("unroll") for (int c = 0; c < NKCH; ++c) ks[c] = *(const bf16x8*)(((MLAK && c == 2) ? k2t_ : kt_) + koff[c]); } while (0)
#define SP_WRITE(b) do { LAS char* vd_ = V_lds + (b) * 16384; LAS char* kd_ = K_lds + (b) * KBY; \
        *(LAS bf16x8*)(vd_ + vst0) = vs0; *(LAS bf16x8*)(vd_ + vst1) = vs1; \
        _Pragma("unroll") for (int c = 0; c < NKCH; ++c) *(LAS bf16x8*)(kd_ + kdst[c]) = ks[c]; } while (0)
#define SP_QKT(P0, P1, b) do { const LAS char* kb_ = K_lds + (b) * KBY + kro; P0 = f32x16{}; P1 = f32x16{}; \
        _Pragma("unroll") for (int d0 = 0; d0 < ND0; ++d0) { const int cb = ((d0 * 16 + hi * 8) * 2) ^ kx; \
            const bf16x8 b0 = *(const LAS bf16x8*)(kb_ + cb); const bf16x8 b1 = *(const LAS bf16x8*)(kb_ + 32 * PITCH + cb); \
            P0 = __builtin_amdgcn_mfma_f32_32x32x16_bf16(b0, qr[d0], P0, 0, 0, 0); P1 = __builtin_amdgcn_mfma_f32_32x32x16_bf16(b1, qr[d0], P1, 0, 0, 0); } } while (0)
#define SP_PART(P0, P1, ALPHA, t) do { \
        float ub = 0.f; bool uni = true;                    \
        if constexpr (BIAS) { const int kq = (t) * 64 - qw0; \
            if (kq + 63 <= -128) ub = tab[0]; else if (kq - 31 >= 128) ub = tab[256]; \
            else { uni = false; _Pragma("unroll") for (int r = 0; r < 16; ++r) { const int i0 = kq + crow(r, hi) - r32 + 128; const int a0 = min(max(i0, 0), 256), a1 = min(max(i0 + 32, 0), 256); \
                    P0[r] = fmaf(P0[r], C, tab[a0]); P1[r] = fmaf(P1[r], C, tab[a1]); } } } \
        float pmax = P0[0]; _Pragma("unroll") for (int r = 1; r < 16; ++r) pmax = fmaxf(pmax, P0[r]); _Pragma("unroll") for (int r = 0; r < 16; ++r) pmax = fmaxf(pmax, P1[r]); \
        { auto rr = __builtin_amdgcn_permlane32_swap(__float_as_uint(pmax), __float_as_uint(pmax), false, false); pmax = fmaxf(__uint_as_float(rr[0]), __uint_as_float(rr[1])); } \
        if constexpr (BIAS) { if (uni) pmax = fmaf(pmax, C, ub); }     \
        const float KS = BIAS ? 1.0f : C;                   \
        float mn; \
        if (__builtin_expect(__all((pmax - m_reg) * KS <= 8.f * LOG2E), 1)) { mn = m_reg; ALPHA = 1.f; } \
        else { mn = fmaxf(m_reg, pmax); ALPHA = __builtin_amdgcn_exp2f((m_reg - mn) * KS); m_reg = mn; } \
        const float mnC = -mn * KS; \
        if constexpr (BIAS) { \
            if (uni) { const float cc = ub + mnC; _Pragma("unroll") for (int r = 0; r < 16; ++r) { P0[r] = fmaf(P0[r], C, cc); P1[r] = fmaf(P1[r], C, cc); } } \
            else { _Pragma("unroll") for (int r = 0; r < 16; ++r) { P0[r] += mnC; P1[r] += mnC; } } } \
        else { _Pragma("unroll") for (int r = 0; r < 16; ++r) { P0[r] = fmaf(P0[r], C, mnC); P1[r] = fmaf(P1[r], C, mnC); } } \
        _Pragma("unroll") for (int r = 0; r < 16; ++r) P0[r] = __builtin_amdgcn_exp2f(P0[r]); } while (0)
#define PK4(P, BASE, OUT) do { unsigned a0 = cvtpk(P[BASE + 0], P[BASE + 1]), a1 = cvtpk(P[BASE + 2], P[BASE + 3]);   \
    unsigned b0 = cvtpk(P[BASE + 4], P[BASE + 5]), b1 = cvtpk(P[BASE + 6], P[BASE + 7]);                              \
    auto r0 = __builtin_amdgcn_permlane32_swap(a0, b0, false, false); auto r1 = __builtin_amdgcn_permlane32_swap(a1, b1, false, false); \
    u32x4 w = {r0[0], r1[0], r0[1], r1[1]}; OUT = *reinterpret_cast<bf16x8*>(&w); } while (0)
#define SP_FIN(P0, P1, ALPHA) do { \
        _Pragma("unroll") for (int r = 0; r < 16; ++r) P1[r] = __builtin_amdgcn_exp2f(P1[r]); \
        float ps = 0.f; _Pragma("unroll") for (int r = 0; r < 16; ++r) ps += P0[r]; _Pragma("unroll") for (int r = 0; r < 16; ++r) ps += P1[r]; \
        { auto rr = __builtin_amdgcn_permlane32_swap(__float_as_uint(ps), __float_as_uint(ps), false, false); ps = __uint_as_float(rr[0]) + __uint_as_float(rr[1]); } \
        l_reg = l_reg * ALPHA + ps; \
        PK4(P0, 0, pa0); PK4(P0, 8, pa1); PK4(P1, 0, pa2); PK4(P1, 8, pa3); } while (0)
#define SP_PV(b) do { const int vb_ = vb0 + (b) * 16384; \
        pv_one<0>(o[0], vb_, pa0, pa1, pa2, pa3); pv_one<1>(o[1], vb_, pa0, pa1, pa2, pa3); pv_one<2>(o[2], vb_, pa0, pa1, pa2, pa3); pv_one<3>(o[3], vb_, pa0, pa1, pa2, pa3); } while (0)
#define SP_RESC(a) do { if (__any((a) < 1.f)) { if (hi == 0) al_l[r32] = (a); asm volatile("s_waitcnt lgkmcnt(0)" ::: "memory"); \
        _Pragma("unroll") for (int r = 0; r < 16; ++r) { const float a_ = al_l[crow(r, hi)]; _Pragma("unroll") for (int d = 0; d < 4; ++d) o[d][r] *= a_; } } } while (0)
    f32x16 pA0, pA1, pB0, pB1; float alA, alB; bf16x8 pa0, pa1, pa2, pa3;
    SP_LOAD(0); __syncthreads(); SP_WRITE(0); __syncthreads();
    SP_QKT(pA0, pA1, 0); SP_PART(pA0, pA1, alA, 0);
    SP_LOAD(1); SP_WRITE(1); __syncthreads();
#pragma nounroll
    for (int j = 1; j + 1 < NT; j += 2) {
        SBAR(); SP_QKT(pB0, pB1, 1);
        SP_FIN(pA0, pA1, alA); SBAR();
        SP_LOAD(j + 1); SBAR();
        SP_PV(0); SP_PART(pB0, pB1, alB, j);
        __syncthreads(); SP_WRITE(0);
        SP_RESC(alB); __syncthreads();
        SBAR(); SP_QKT(pA0, pA1, 0);
        SP_FIN(pB0, pB1, alB); SBAR();
        SP_LOAD(j + 2); SBAR();
        SP_PV(1); SP_PART(pA0, pA1, alA, j + 1);
        __syncthreads(); SP_WRITE(1);
        SP_RESC(alA); __syncthreads();
    }
    SBAR(); SP_QKT(pB0, pB1, 1);
    SP_FIN(pA0, pA1, alA); SBAR();
    SP_PV(0); SP_PART(pB0, pB1, alB, NT - 1);
    SP_RESC(alB);
    SP_FIN(pB0, pB1, alB); SBAR();
    SP_PV(1);
    if (hi == 0) li_l[r32] = l_reg;
    asm volatile("s_waitcnt lgkmcnt(0)" ::: "memory");
#pragma unroll
    for (int r = 0; r < 16; ++r) { const float rl = 1.0f / li_l[crow(r, hi)];
#pragma unroll
        for (int d = 0; d < 4; ++d) o[d][r] *= rl; }
#undef SP_LOAD
#undef SP_WRITE
#undef SP_QKT
#undef SP_PART
#undef PK4
#undef SP_FIN
#undef SP_PV
#undef SP_RESC
}

template <int DQK, bool MLAK, bool BIAS, int QL  , bool KPF  >
__device__ __forceinline__ void attn_core_sp3(f32x16 (&o)[4], const bf16x8 (&qr)[DQK / 16],
                                             const bf16_t* __restrict__ Kg, int ldk, const bf16_t* __restrict__ K2g, const bf16_t* __restrict__ Vg, int ldv,
                                             int nkeys, float C, int qw0, LAS char* lds) {
    constexpr int PITCH = DQK * 2, KBY = 64 * PITCH, CPR = DQK / 8, NKCH = DQK / 64, ND0 = DQK / 16;
    constexpr int L_V = 0, L_K = 49152, L_WS = L_K + 2 * KBY, L_TAB = L_WS + 2048, L_Q = L_TAB + 2048, QR = ND0 - QL;
    static_assert(!MLAK, "head-major K only");
    const int tid = otid(), wid = __builtin_amdgcn_readfirstlane(tid >> 6), lane = tid & 63, r32 = lane & 31, hi = lane >> 5;
    LAS char* V_lds = lds + L_V; LAS char* K_lds = lds + L_K;
    LAS float* wsf = (LAS float*)(lds + L_WS) + wid * 64; LAS float* li_l = wsf; LAS float* al_l = wsf + 32;
    const LAS float* tab = (const LAS float*)(lds + L_TAB);
    unsigned koff[NKCH], voff[2];
#pragma unroll
    for (int c = 0; c < NKCH; ++c) { const int pos = (wid * NKCH + c) * 1024 + lane * 16, row = pos / PITCH, sch = (pos % PITCH) >> 4;
        koff[c] = (unsigned)(row * ldk + ((sch ^ ((row >> 1) & 7)) << 3)); }
#pragma unroll
    for (int c = 0; c < 2; ++c) { const int pos = (wid * 2 + c) * 1024 + lane * 16, sub = pos >> 9, within = pos & 511;
        const int kk = (sub >> 2) * 8 + (within >> 6), k = (kk & ~0xC) | ((kk & 4) << 1) | ((kk & 8) >> 1), col = (sub & 3) * 32 + ((within & 63) >> 1);
        voff[c] = (unsigned)(k * ldv + col); }
    const int vb0 = (int)(unsigned)(uintptr_t)V_lds + v_rd_base(lane);
    const int kro = r32 * PITCH, kx = ((r32 >> 1) & 7) << 4;
    const LAS char* kcp[4];
#pragma unroll
    for (int m = 0; m < 4; ++m) kcp[m] = K_lds + kro + ((m * 32 + hi * 16) ^ kx);
    constexpr bool PNEG = (DQK == 192);
    f32x16 negm_ = f32x16{}; float nb_cur = 0.f;
    if (PNEG) asm volatile("" : "+v"(negm_));
    float m_reg = 0.f, l_reg = 0.f;
#pragma unroll
    for (int d = 0; d < 4; ++d) o[d] = f32x16{};
    const int NT = nkeys / 64;
    LAS char* q_lds = lds + L_Q + wid * (QL > 0 ? QL : 1) * 1024 + lane * 16;
    if constexpr (QL > 0) {
#pragma unroll
        for (int d0 = QR; d0 < ND0; ++d0) *(LAS bf16x8*)(q_lds + (d0 - QR) * 1024) = qr[d0];
    }
#define SP_SYNC() do { asm volatile("s_waitcnt vmcnt(0)" ::: "memory"); __syncthreads(); } while (0)
#define SP_DMA(t) do { const bf16_t* vt_ = Vg + (size_t)(t) * 64 * ldv; const bf16_t* kt_ = Kg + (size_t)(t) * 64 * ldk; const int sl_ = (t) % 3;   \
        _Pragma("unroll") for (int c = 0; c < NKCH; ++c) __builtin_amdgcn_global_load_lds((const unsigned*)(kt_ + koff[c]), (LAS unsigned*)(K_lds + ((t) & 1) * KBY + (wid * NKCH + c) * 1024), 16, 0, 0); \
        _Pragma("unroll") for (int c = 0; c < 2; ++c) __builtin_amdgcn_global_load_lds((const unsigned*)(vt_ + voff[c]), (LAS unsigned*)(V_lds + sl_ * 16384 + (wid * 2 + c) * 1024), 16, 0, 0); } while (0)
#define SP_KRD(dst, d0_) do { const LAS char* ka_ = kcp[(d0_) & 3] + ks_ + ((d0_) >> 2) * 128; dst[0] = *(const LAS bf16x8*)(ka_); dst[1] = *(const LAS bf16x8*)(ka_ + 32 * PITCH); } while (0)
#define SP_QMM(src, d0_) do { bf16x8 qf_; if ((d0_) < QR) qf_ = qr[(d0_) < QR ? (d0_) : 0]; else qf_ = *(const LAS bf16x8*)(q_lds + ((d0_) - QR) * 1024); \
        if ((d0_) == 0) { P0_ = __builtin_amdgcn_mfma_f32_32x32x16_bf16(src[0], qf_, negm_, 0, 0, 0); P1_ = __builtin_amdgcn_mfma_f32_32x32x16_bf16(src[1], qf_, negm_, 0, 0, 0); } \
        else { P0_ = __builtin_amdgcn_mfma_f32_32x32x16_bf16(src[0], qf_, P0_, 0, 0, 0); P1_ = __builtin_amdgcn_mfma_f32_32x32x16_bf16(src[1], qf_, P1_, 0, 0, 0); } } while (0)
#define SP_QKT(P0, P1, b, t) do { const int ks_ = (b) * KBY; f32x16 P0_, P1_; \
        { float nb_ = -m_reg;                \
          if constexpr (BIAS) { const int kq_ = (t) * 64 - qw0; if (kq_ + 63 <= -128) nb_ += tab[0]; else if (kq_ - 31 >= 128) nb_ += tab[447]; } \
          if (!PNEG || __any(nb_ != nb_cur)) { nb_cur = nb_; _Pragma("unroll") for (int r = 0; r < 16; ++r) negm_[r] = nb_; if (PNEG) asm volatile("" : "+v"(negm_)); } }     \
        if constexpr (KPF) { bf16x8 kfa[2], kfb[2]; SP_KRD(kfa, 0); \
            _Pragma("unroll") for (int d0 = 0; d0 < ND0; ++d0) { \
                if (d0 + 1 < ND0) { if (d0 & 1) SP_KRD(kfa, d0 + 1); else SP_KRD(kfb, d0 + 1); } \
                __builtin_amdgcn_sched_barrier(0x6); \
                if (d0 & 1) SP_QMM(kfb, d0); else SP_QMM(kfa, d0); \
                __builtin_amdgcn_sched_barrier(0x6); } } \
        else { _Pragma("unroll") for (int d0 = 0; d0 < ND0; ++d0) { bf16x8 kf_[2]; SP_KRD(kf_, d0); SP_QMM(kf_, d0); if ((d0 & 1) == 1) __builtin_amdgcn_sched_barrier(0x6); } } \
        P0 = P0_; P1 = P1_; } while (0)
#define SP_PART(P0, P1, ALPHA, t, FIRST) do { \
        if constexpr (BIAS) { const int kq = (t) * 64 - qw0; \
            if (!(kq + 63 <= -128) && !(kq - 31 >= 128)) { const LAS float* tb_ = tab + (kq + 224 - r32 + 4 * hi);     \
                _Pragma("unroll") for (int r = 0; r < 16; ++r) { P0[r] += tb_[(r & 3) + 8 * (r >> 2)]; P1[r] += tb_[(r & 3) + 8 * (r >> 2) + 32]; } } } \
        float pmax = P0[0]; _Pragma("unroll") for (int r = 1; r < 16; ++r) pmax = fmaxf(pmax, P0[r]); _Pragma("unroll") for (int r = 0; r < 16; ++r) pmax = fmaxf(pmax, P1[r]); \
        { auto rr = __builtin_amdgcn_permlane32_swap(__float_as_uint(pmax), __float_as_uint(pmax), false, false); pmax = fmaxf(__uint_as_float(rr[0]), __uint_as_float(rr[1])); } \
          \
        if ((FIRST) || !__builtin_expect(__all(pmax <= 8.f * LOG2E), 1)) { const float dl = (FIRST) ? pmax : fmaxf(pmax, 0.f); m_reg += dl; \
            _Pragma("unroll") for (int r = 0; r < 16; ++r) { P0[r] -= dl; P1[r] -= dl; } \
            ALPHA = (FIRST) ? 1.f : __builtin_amdgcn_exp2f(-dl); } \
        else ALPHA = 1.f; \
        _Pragma("unroll") for (int r = 0; r < 16; ++r) P0[r] = __builtin_amdgcn_exp2f(P0[r]); } while (0)
#define PK4(P, BASE, OUT) do { unsigned a0 = cvtpk(P[BASE + 0], P[BASE + 1]), a1 = cvtpk(P[BASE + 2], P[BASE + 3]);   \
    unsigned b0 = cvtpk(P[BASE + 4], P[BASE + 5]), b1 = cvtpk(P[BASE + 6], P[BASE + 7]);                              \
    auto r0 = __builtin_amdgcn_permlane32_swap(a0, b0, false, false); auto r1 = __builtin_amdgcn_permlane32_swap(a1, b1, false, false); \
    u32x4 w = {r0[0], r1[0], r0[1], r1[1]}; OUT = *reinterpret_cast<bf16x8*>(&w); } while (0)
#define SP_FIN(P0, P1, ALPHA) do { \
        _Pragma("unroll") for (int r = 0; r < 16; ++r) P1[r] = __builtin_amdgcn_exp2f(P1[r]); \
        float ps = 0.f; _Pragma("unroll") for (int r = 0; r < 16; ++r) ps += P0[r]; _Pragma("unroll") for (int r = 0; r < 16; ++r) ps += P1[r]; \
        { auto rr = __builtin_amdgcn_permlane32_swap(__float_as_uint(ps), __float_as_uint(ps), false, false); ps = __uint_as_float(rr[0]) + __uint_as_float(rr[1]); } \
        l_reg = l_reg * ALPHA + ps; \
        PK4(P0, 0, pa0); PK4(P0, 8, pa1); PK4(P1, 0, pa2); PK4(P1, 8, pa3); } while (0)
#define SP_PV(b) do { const int vb_ = vb0 + (b) * 16384; \
        pv_one<0>(o[0], vb_, pa0, pa1, pa2, pa3); pv_one<1>(o[1], vb_, pa0, pa1, pa2, pa3); pv_one<2>(o[2], vb_, pa0, pa1, pa2, pa3); pv_one<3>(o[3], vb_, pa0, pa1, pa2, pa3); } while (0)
#define SP_RESC(a) do { if (__any((a) < 1.f)) { if (hi == 0) al_l[r32] = (a); asm volatile("s_waitcnt lgkmcnt(0)" ::: "memory"); \
        _Pragma("unroll") for (int r = 0; r < 16; ++r) { const float a_ = al_l[crow(r, hi)]; _Pragma("unroll") for (int d = 0; d < 4; ++d) o[d][r] *= a_; } } } while (0)
    f32x16 pA0, pA1, pB0, pB1; float alA, alB; bf16x8 pa0, pa1, pa2, pa3;
    SP_SYNC(); SP_DMA(0); SP_SYNC();
    SP_QKT(pA0, pA1, 0, 0); SP_PART(pA0, pA1, alA, 0, true);
    SP_DMA(1); SP_SYNC();
#pragma nounroll
    for (int j = 1; j + 1 < NT; j += 2) {
        SBAR(); SP_QKT(pB0, pB1, j & 1, j);
        SP_FIN(pA0, pA1, alA); SBAR();
        SP_DMA(j + 1); SBAR();
        SP_PV((j - 1) % 3); SP_PART(pB0, pB1, alB, j, false);
        SP_RESC(alB); SP_SYNC();
        SBAR(); SP_QKT(pA0, pA1, (j + 1) & 1, j + 1);
        SP_FIN(pB0, pB1, alB); SBAR();
        if (j + 2 < NT) SP_DMA(j + 2); SBAR();
        SP_PV(j % 3); SP_PART(pA0, pA1, alA, j + 1, false);
        SP_RESC(alA); SP_SYNC();
    }
    SBAR(); SP_QKT(pB0, pB1, (NT - 1) & 1, NT - 1);
    SP_FIN(pA0, pA1, alA); SBAR();
    SP_PV((NT - 2) % 3); SP_PART(pB0, pB1, alB, NT - 1, false);
    SP_RESC(alB);
    SP_FIN(pB0, pB1, alB); SBAR();
    SP_PV((NT - 1) % 3);
    if (hi == 0) li_l[r32] = l_reg;
    asm volatile("s_waitcnt lgkmcnt(0)" ::: "memory");
#pragma unroll
    for (int r = 0; r < 16; ++r) { const float rl = 1.0f / li_l[crow(r, hi)];
#pragma unroll
        for (int d = 0; d < 4; ++d) o[d][r] *= rl; }
#undef SP_DMA
#undef SP_SYNC
#undef SP_QKT
#undef SP_KRD
#undef SP_QMM
#undef SP_PART
#undef PK4
#undef SP_FIN
#undef SP_PV
#undef SP_RESC
}

template <int DQK>
__device__ __forceinline__ void attn_core_x(f32x16 (&o)[4], const bf16x8 (&qr)[DQK / 16], const bf16_t* __restrict__ Kg, int ldk, const bf16_t* __restrict__ Vg, int ldv,
                                            int nkeys, float C, LAS char* lds) {
    constexpr int PITCH = DQK * 2, KBY = 64 * PITCH, NKCH = DQK / 64, ND0 = DQK / 16;
    constexpr int L_V = 0, L_K = 32768, L_WS = L_K + 2 * KBY;
    const int tid = otid(), wid = __builtin_amdgcn_readfirstlane(tid >> 6), lane = tid & 63, r32 = lane & 31, hi = lane >> 5;
    LAS char* V_lds = lds + L_V; LAS char* K_lds = lds + L_K;
    LAS float* wsf = (LAS float*)(lds + L_WS) + wid * 64; LAS float* li_l = wsf; LAS float* al_l = wsf + 32;
    unsigned koff[NKCH], voff[2];
#pragma unroll
    for (int c = 0; c < NKCH; ++c) { const int pos = (wid * NKCH + c) * 1024 + lane * 16, row = pos / PITCH, sch = (pos % PITCH) >> 4;
        koff[c] = (unsigned)(row * ldk + ((sch ^ ((row >> 1) & 7)) << 3)); }
#pragma unroll
    for (int c = 0; c < 2; ++c) { const int pos = (wid * 2 + c) * 1024 + lane * 16, sub = pos >> 9, within = pos & 511;
        const int kk = (sub >> 2) * 8 + (within >> 6), k = (kk & ~0xC) | ((kk & 4) << 1) | ((kk & 8) >> 1), col = (sub & 3) * 32 + ((within & 63) >> 1);
        voff[c] = (unsigned)(k * ldv + col); }
    const int vb0 = (int)(unsigned)(uintptr_t)V_lds + v_rd_base(lane);
    const int kro = r32 * PITCH, kx = ((r32 >> 1) & 7) << 4;
    const LAS char* kcp[4];
#pragma unroll
    for (int m = 0; m < 4; ++m) kcp[m] = K_lds + kro + ((m * 32 + hi * 16) ^ kx);
    float m_reg = -1e30f, l_reg = 0.f;
#pragma unroll
    for (int d = 0; d < 4; ++d) o[d] = f32x16{};
    const int NT = nkeys / 64;
#define X_DMA(t) do { const bf16_t* vt_ = Vg + (size_t)(t) * 64 * ldv; const bf16_t* kt_ = Kg + (size_t)(t) * 64 * ldk; const int sl_ = (t) & 1; \
        _Pragma("unroll") for (int c = 0; c < NKCH; ++c) __builtin_amdgcn_global_load_lds((const unsigned*)(kt_ + koff[c]), (LAS unsigned*)(K_lds + sl_ * KBY + (wid * NKCH + c) * 1024), 16, 0, 0); \
        _Pragma("unroll") for (int c = 0; c < 2; ++c) __builtin_amdgcn_global_load_lds((const unsigned*)(vt_ + voff[c]), (LAS unsigned*)(V_lds + sl_ * 16384 + (wid * 2 + c) * 1024), 16, 0, 0); } while (0)
#define X_BAR() do { SBAR(); asm volatile("s_waitcnt lgkmcnt(0)\n\ts_barrier" ::: "memory"); SBAR(); } while (0)
    asm volatile("s_waitcnt vmcnt(0)" ::: "memory");
    __syncthreads();
    X_DMA(0);
#pragma nounroll
    for (int j = 0; j < NT; ++j) {
        if (j + 1 < NT) { X_DMA(j + 1); asm volatile("s_waitcnt vmcnt(%0)" :: "n"(NKCH + 2) : "memory"); }
        else asm volatile("s_waitcnt vmcnt(0)" ::: "memory");
        X_BAR();
        const int ks_ = (j & 1) * KBY;
        f32x16 p0 = f32x16{}, p1 = f32x16{};
        {
#define X_KRD(dst, d0_) do { const LAS char* ka_ = kcp[(d0_) & 3] + ks_ + ((d0_) >> 2) * 128; dst[0] = *(const LAS bf16x8*)(ka_); dst[1] = *(const LAS bf16x8*)(ka_ + 32 * PITCH); } while (0)
            bf16x8 kfa[2], kfb[2]; X_KRD(kfa, 0);
#pragma unroll
            for (int d0 = 0; d0 < ND0; ++d0) {
                if (d0 + 1 < ND0) { if (d0 & 1) X_KRD(kfa, d0 + 1); else X_KRD(kfb, d0 + 1); }
                __builtin_amdgcn_sched_barrier(0x6);
                if (d0 & 1) { p0 = __builtin_amdgcn_mfma_f32_32x32x16_bf16(kfb[0], qr[d0], p0, 0, 0, 0); p1 = __builtin_amdgcn_mfma_f32_32x32x16_bf16(kfb[1], qr[d0], p1, 0, 0, 0); }
                else { p0 = __builtin_amdgcn_mfma_f32_32x32x16_bf16(kfa[0], qr[d0], p0, 0, 0, 0); p1 = __builtin_amdgcn_mfma_f32_32x32x16_bf16(kfa[1], qr[d0], p1, 0, 0, 0); }
                __builtin_amdgcn_sched_barrier(0x6); }
#undef X_KRD
        }
        float pmax = fmaxf(p0[0], p1[0]);
#pragma unroll
        for (int r = 1; r < 16; ++r) pmax = fmaxf(fmaxf(pmax, p0[r]), p1[r]);
        { auto rr = __builtin_amdgcn_permlane32_swap(__float_as_uint(pmax), __float_as_uint(pmax), false, false); pmax = fmaxf(__uint_as_float(rr[0]), __uint_as_float(rr[1])); }
        pmax *= C;
        const float mn = fmaxf(m_reg, pmax); const float alpha = __builtin_amdgcn_exp2f(m_reg - mn); m_reg = mn;
        float ps = 0.f;
#pragma unroll
        for (int r = 0; r < 16; ++r) { p0[r] = __builtin_amdgcn_exp2f(fmaf(p0[r], C, -mn)); p1[r] = __builtin_amdgcn_exp2f(fmaf(p1[r], C, -mn)); ps += p0[r] + p1[r]; }
        { auto rr = __builtin_amdgcn_permlane32_swap(__float_as_uint(ps), __float_as_uint(ps), false, false); ps = __uint_as_float(rr[0]) + __uint_as_float(rr[1]); }
        l_reg = l_reg * alpha + ps;
        if (__any(alpha < 1.f)) { if (hi == 0) al_l[r32] = alpha; asm volatile("s_waitcnt lgkmcnt(0)" ::: "memory");
#pragma unroll
            for (int r = 0; r < 16; ++r) { const float a = al_l[crow(r, hi)];
#pragma unroll
                for (int d = 0; d < 4; ++d) o[d][r] *= a; } }
        bf16x8 pa0, pa1, pa2, pa3;
#define PK4(P, BASE, OUT) do { unsigned a0 = cvtpk(P[BASE + 0], P[BASE + 1]), a1 = cvtpk(P[BASE + 2], P[BASE + 3]);   \
    unsigned b0 = cvtpk(P[BASE + 4], P[BASE + 5]), b1 = cvtpk(P[BASE + 6], P[BASE + 7]);                              \
    auto r0 = __builtin_amdgcn_permlane32_swap(a0, b0, false, false); auto r1 = __builtin_amdgcn_permlane32_swap(a1, b1, false, false); \
    u32x4 w = {r0[0], r1[0], r0[1], r1[1]}; OUT = *reinterpret_cast<bf16x8*>(&w); } while (0)
        PK4(p0, 0, pa0); PK4(p0, 8, pa1); PK4(p1, 0, pa2); PK4(p1, 8, pa3);
#undef PK4
        SBAR();
        const int vb_ = vb0 + (j & 1) * 16384;
        pv_one<0>(o[0], vb_, pa0, pa1, pa2, pa3); pv_one<1>(o[1], vb_, pa0, pa1, pa2, pa3); pv_one<2>(o[2], vb_, pa0, pa1, pa2, pa3); pv_one<3>(o[3], vb_, pa0, pa1, pa2, pa3);
        X_BAR();
    }
    if (hi == 0) li_l[r32] = l_reg;
    asm volatile("s_waitcnt lgkmcnt(0)" ::: "memory");
#pragma unroll
    for (int r = 0; r < 16; ++r) { const float rl = 1.0f / li_l[crow(r, hi)];
#pragma unroll
        for (int d = 0; d < 4; ++d) o[d][r] *= rl; }
#undef X_DMA
#undef X_BAR
}

__device__ __forceinline__ void store_o(const f32x16 (&o)[4], bf16_t* Ob, int ldo, int r32, int hi) {
#pragma unroll
    for (int r = 0; r < 16; ++r) { bf16_t* p = Ob + (size_t)crow(r, hi) * ldo + r32;
#pragma unroll
        for (int d0 = 0; d0 < 4; ++d0) p[d0 * 32] = (bf16_t)(cvtpk(o[d0][r], 0.f) & 0xffffu); }
}
}

__device__ __forceinline__ void self_unit(int u, int& seqbase, int& S, int& h, int& qb) {
    if (u < 2048) { const int round = u >> 8, v = u & 255, x = v >> 5, j = v & 31; const int pair = x * 8 + round; S = SS; seqbase = MP + (pair >> 3) * SS; h = pair & 7; qb = j; }
    else { const int u2 = u - 2048, round = u2 >> 8, v = u2 & 255, x = v >> 5, j = v & 31; const int pair = x * 4 + round * 2 + (j >> 4); S = SP; seqbase = (pair >> 3) * SP; h = pair & 7; qb = j & 15; }
}

__device__ __forceinline__ void phase_mla_attn(const Params& P, LAS char* lds, int vcu, int G) {
    const int tid = otid(), wid = tid >> 6, lane = tid & 63, r32 = lane & 31, hi = lane >> 5;
    const bf16_t* Q = (const bf16_t*)(P.ws + O_Q); const bf16_t* KH = (const bf16_t*)(P.ws + O_KH); const bf16_t* VH = (const bf16_t*)(P.ws + O_VH);
    bf16_t* O = (bf16_t*)(P.ws + O_O);
    const float* cosT = (const float*)(P.ws + O_COS); const float* sinT = (const float*)(P.ws + O_SIN);
    const float C = 0.07216878364870323f * LOG2E;
#if PROBE_SEL
    if (blockIdx.x == 0 && tid == 0) { unsigned long long* pb = (unsigned long long*)(P.ws + 4096); for (int i = 0; i < 16; ++i) pb[i] = 0; pb[16] = __builtin_readcyclecounter(); pb[17] = __builtin_amdgcn_s_memrealtime(); }
    __syncthreads();
#endif
#pragma nounroll
    for (int u = vcu; u < 2560; u += G) {
        int seqbase, S, h, qb; self_unit(u, seqbase, S, h, qb);
        const int pos = qb * 256 + wid * 32 + r32; const size_t row = (size_t)seqbase + pos;
        const bf16_t* qp = Q + row * 1536 + h * 192 + hi * 8;
        bf16x8 qr[12];
#pragma unroll
        for (int d0 = 0; d0 < 12; ++d0) qr[d0] = *(const bf16x8*)(qp + d0 * 16);
#pragma unroll
        for (int pr = 0; pr < 2; ++pr) { const int i0 = pr * 16 + hi * 8;
            const f32x4 c0 = *(const f32x4*)(cosT + pos * 32 + i0), c1 = *(const f32x4*)(cosT + pos * 32 + i0 + 4);
            const f32x4 s0 = *(const f32x4*)(sinT + pos * 32 + i0), s1 = *(const f32x4*)(sinT + pos * 32 + i0 + 4);
            const float cs[8] = {c0.x, c0.y, c0.z, c0.w, c1.x, c1.y, c1.z, c1.w}, sn[8] = {s0.x, s0.y, s0.z, s0.w, s1.x, s1.y, s1.z, s1.w};
            const bf16x8 x1 = qr[8 + pr], x2 = qr[10 + pr]; float o1[8], o2[8];
#pragma unroll
            for (int e = 0; e < 8; ++e) { const float a = bf1(x1[e]), b = bf1(x2[e]); o1[e] = a * cs[e] - b * sn[e]; o2[e] = a * sn[e] + b * cs[e]; }
            u32x4 w1 = {cvtpk(o1[0], o1[1]), cvtpk(o1[2], o1[3]), cvtpk(o1[4], o1[5]), cvtpk(o1[6], o1[7])};
            u32x4 w2 = {cvtpk(o2[0], o2[1]), cvtpk(o2[2], o2[3]), cvtpk(o2[4], o2[5]), cvtpk(o2[6], o2[7])};
            qr[8 + pr] = __builtin_bit_cast(bf16x8, w1); qr[10 + pr] = __builtin_bit_cast(bf16x8, w2); }
#pragma unroll
        for (int d0 = 0; d0 < 12; ++d0) qr[d0] = scale_frag(qr[d0], C);
        f32x16 o[4];
        att::attn_core_sp3<192, false, false, 7, true>(o, qr, KH + ((size_t)h * MT + seqbase) * 192, 192, nullptr, VH + ((size_t)h * MT + seqbase) * 128, 128, S, C, 0, lds);
        att::store_o(o, O + ((size_t)seqbase + qb * 256 + wid * 32) * 1024 + h * 128, 1024, r32, hi);
    }
#if PROBE_SEL
    if (blockIdx.x == 0 && tid == 0) { unsigned long long* pb = (unsigned long long*)(P.ws + 4096); pb[18] = __builtin_readcyclecounter(); pb[19] = __builtin_amdgcn_s_memrealtime(); }
#endif
}

__device__ __forceinline__ void phase_xattn(const Params& P, int layer, LAS char* lds, int vcu, int G) {
    const int tid = otid(), wid = tid >> 6, lane = tid & 63, r32 = lane & 31, hi = lane >> 5;
    const bf16_t* XQ = (const bf16_t*)(P.ws + O_XQ); const bf16_t* MKV = (const bf16_t*)(P.ws + O_MKV) + (size_t)layer * NMR * 2048;
    bf16_t* O = (bf16_t*)(P.ws + O_O);
    const float C = 0.0625f * LOG2E;
#pragma nounroll
    for (int u = vcu; u < 2560; u += G) {
        const int vh = u & 1, h = (u >> 1) & 3, t = u >> 3; const int tok0 = t * 256;
        const int batch = tok0 < MP ? tok0 / SP : 4 + (tok0 - MP) / SS;
        const size_t row = (size_t)tok0 + wid * 32 + r32;
        const bf16_t* qp = XQ + row * 1024 + h * 256 + hi * 8;
        bf16x8 qr[16];
#pragma unroll
        for (int d0 = 0; d0 < 16; ++d0) qr[d0] = *(const bf16x8*)(qp + d0 * 16);
        const bf16_t* kb = MKV + (size_t)batch * 256 * 2048 + h * 256;
        f32x16 o[4];
        att::attn_core_x<256>(o, qr, kb, 2048, kb + 1024 + vh * 128, 2048, 256, C, lds);
        att::store_o(o, O + ((size_t)tok0 + wid * 32) * 1024 + h * 256 + vh * 128, 1024, r32, hi);
    }
}

__device__ __forceinline__ void phase_diff_attn(const Params& P, LAS char* lds, int vcu, int G) {
    const int tid = otid(), wid = tid >> 6, lane = tid & 63, r32 = lane & 31, hi = lane >> 5;
    const bf16_t* DQ = (const bf16_t*)(P.ws + O_DQ); const bf16_t* DKH = (const bf16_t*)(P.ws + O_DKH); const bf16_t* DVH = (const bf16_t*)(P.ws + O_DVH); bf16_t* O = (bf16_t*)(P.ws + O_O);
    const float* lam = P.in[13]; const float* subln = P.in[14]; const float* rbt = P.in[5];
    const float la = wave_sum(lam[lane] * lam[64 + lane]), lb = wave_sum(lam[128 + lane] * lam[192 + lane]);
    const float lam_full = expf(la) - expf(lb) + LAMBDA_INIT;
    const float C = 0.125f * LOG2E;
    LAS float* tab = (LAS float*)(lds + 67584);
    float sg[4];
#pragma unroll
    for (int d0 = 0; d0 < 4; ++d0) sg[d0] = subln[d0 * 32 + r32] * (1.0f - LAMBDA_INIT);
#pragma nounroll
    for (int u = vcu; u < 2560; u += G) {
        int seqbase, S, h, qb; self_unit(u, seqbase, S, h, qb);
        __syncthreads();
        for (int idx = tid; idx < 448; idx += 512) { const int rel = min(max(idx - 224, -128), 128), n = rel < 0 ? -rel : rel;
            int b = n < 8 ? n : (n < 12 ? 8 : n < 16 ? 9 : n < 23 ? 10 : n < 32 ? 11 : n < 46 ? 12 : n < 64 ? 13 : n < 91 ? 14 : 15);
            if (rel > 0) b += 16;
            tab[idx] = rbt[b * 8 + h] * LOG2E; }
        const int qw0 = qb * 256 + wid * 32; const size_t row = (size_t)seqbase + qw0 + r32;
        const bf16_t* kb = DKH + ((size_t)h * MT + seqbase) * 128; const bf16_t* vb = DVH + ((size_t)h * MT + seqbase) * 128;
        f32x16 oa[4], ob[4];
        LAS unsigned* stash = (LAS unsigned*)(lds + 69632) + tid;
        { bf16x8 qr[4]; const bf16_t* qp = DQ + row * 1024 + h * 128 + hi * 8;
#pragma unroll
          for (int d0 = 0; d0 < 4; ++d0) qr[d0] = scale_frag(*(const bf16x8*)(qp + d0 * 16), C);
          att::attn_core_sp3<64, false, true, 0, true>(oa, qr, kb, 128, nullptr, vb, 128, S, C, qw0, lds); }
#pragma unroll
        for (int d0 = 0; d0 < 4; ++d0)
#pragma unroll
            for (int r = 0; r < 16; r += 2) stash[(d0 * 8 + (r >> 1)) * 512] = cvtpk(oa[d0][r], oa[d0][r + 1]);
        { bf16x8 qr[4]; const bf16_t* qp = DQ + row * 1024 + h * 128 + 64 + hi * 8;
#pragma unroll
          for (int d0 = 0; d0 < 4; ++d0) qr[d0] = scale_frag(*(const bf16x8*)(qp + d0 * 16), C);
          att::attn_core_sp3<64, false, true, 0, true>(ob, qr, kb + 64, 128, nullptr, vb, 128, S, C, qw0, lds); }
#pragma unroll
        for (int r = 0; r < 16; ++r) { float s = 0.f;
#pragma unroll
            for (int d0 = 0; d0 < 4; ++d0) { const unsigned w = stash[(d0 * 8 + (r >> 1)) * 512]; const float a = (r & 1) ? bfhi(w) : bflo(w); const float v = a - lam_full * ob[d0][r]; oa[d0][r] = v; s += v * v; }
            s = half_sum(s);
            const float rs = 1.0f / sqrtf(s * (1.f / 128.f) + EPS);
#pragma unroll
            for (int d0 = 0; d0 < 4; ++d0) oa[d0][r] *= rs * sg[d0]; }
        att::store_o(oa, O + ((size_t)seqbase + qw0) * 1024 + h * 128, 1024, r32, hi);
    }
}

struct GemmDesc { const bf16_t* A; const bf16_t* Bt; bf16_t* C; int M, N, K, act; int mode; bf16_t* C2; bf16_t* C3; };
__device__ __forceinline__ int gemm_desc(int ph, int sub, unsigned char* ws, GemmDesc& d) {
#define BP(off) ((bf16_t*)(ws + (off)))
    const int L = ph >= 14 ? 1 : 0;
    switch (ph) {
    case 1:
        if (sub < 2) { d = GemmDesc{BP(O_MEMN) + (size_t)sub * NMR * 1024, BP(O_W_XKV + (size_t)sub * 4 * MiB), BP(O_MKV) + (size_t)sub * NMR * 2048, NMR, 2048, 1024, 0, 0, nullptr, nullptr}; }
        else { d = GemmDesc{BP(O_XH), BP(O_W_MLA_IN), BP(O_C), MT, 768, 1024, 0, 0, nullptr, nullptr}; }
        return 3;
    case 3:
        if (sub == 0) d = GemmDesc{BP(O_CNQ), BP(O_W_MLA_UQ), BP(O_Q), MT, 1536, 256, 0, 0, nullptr, nullptr};
        else d = GemmDesc{BP(O_CNKV), BP(O_W_MLA_UKV), nullptr, MT, 2048, 256, 0, 1, BP(O_KH), BP(O_VH)};
        return 2;
    case 5: d = GemmDesc{BP(O_O), BP(O_W_MLA_O), BP(O_XH), MT, 1024, 1024, 0, 0, nullptr, nullptr}; return 1;
    case 7: case 18: d = GemmDesc{BP(O_XH), BP(O_W_XQ + (size_t)L * 2 * MiB), BP(O_XQ), MT, 1024, 1024, 0, 0, nullptr, nullptr}; return 1;
    case 9: case 20: d = GemmDesc{BP(O_O), BP(O_W_XO + (size_t)L * 2 * MiB), BP(O_XH), MT, 1024, 1024, 0, 0, nullptr, nullptr}; return 1;
    case 11: case 22: d = GemmDesc{BP(O_XH), BP(O_W_1 + (size_t)L * 8 * MiB), BP(O_ACT), MT, 4096, 1024, 1, 0, nullptr, nullptr}; return 1;
    case 12: case 23: d = GemmDesc{BP(O_ACT), BP(O_W_2 + (size_t)L * 8 * MiB), BP(O_XH), MT, 1024, 4096, 0, 0, nullptr, nullptr}; return 1;
    case 14: d = GemmDesc{BP(O_XH), BP(O_W_DIFF_IN), BP(O_DQ), MT, 3072, 1024, 0, 2, BP(O_DKH), BP(O_DVH)}; return 1;
    case 16: d = GemmDesc{BP(O_O), BP(O_W_DIFF_O), BP(O_XH), MT, 1024, 1024, 0, 0, nullptr, nullptr}; return 1;
    default: return 0;
    }
#undef BP
}

#define XB_TMO      128
#define XB_XCNT(j)  (256  + 64 * (j))
#define XB_XSUB(j)  (1280 + 64 * (j))
#define XB_XGEN(j)  (2304 + 64 * (j))
#define XB_TOP      3328
#define XB_TOPGEN   3392
#define XCD_BAR_WORDS 3456
#define XB_SPIN_CAP (1u << 18)

__device__ __forceinline__ unsigned xb_ld(unsigned* p)              { return __hip_atomic_load(p, __ATOMIC_RELAXED, __HIP_MEMORY_SCOPE_AGENT); }
__device__ __forceinline__ unsigned xb_add(unsigned* p, unsigned v) { return __hip_atomic_fetch_add(p, v, __ATOMIC_RELAXED, __HIP_MEMORY_SCOPE_AGENT); }
__device__ __forceinline__ unsigned xb_xcc_id() { return (unsigned)__builtin_amdgcn_s_getreg((3 << 11) | 20) & 0xFu; }
#define XB_SPIN(cond, bar) do { unsigned _sp = 0; while (cond) { __builtin_amdgcn_s_sleep(1); \
    if ((++_sp & 255u) == 0u) { if (xb_ld(&(bar)[XB_TMO])) break; if (_sp > XB_SPIN_CAP) { atomicAdd(&(bar)[XB_TMO], 1u); break; } } } } while (0)

struct XcdBarrier {
    unsigned* bar; unsigned x;
    volatile LAS unsigned* st;
};

__device__ __forceinline__ XcdBarrier xcd_barrier_post(unsigned* bar, volatile LAS unsigned* st) {
    XcdBarrier b; b.bar = bar; b.x = xb_xcc_id(); b.st = st;
    if (threadIdx.x == 0) (void)xb_add(&bar[XB_XCNT(b.x)], 1u);
    return b;
}
__device__ __forceinline__ void xcd_barrier_complete(unsigned* bar, unsigned x, unsigned& nloc, unsigned& nx) {
    const unsigned G = gridDim.x * gridDim.y * gridDim.z;
    unsigned sum, cnt, mine, sp = 0u;
    for (;;) {
        sum = 0u; cnt = 0u; mine = 0u;
#pragma unroll
        for (unsigned j = 0; j < 16; ++j) { const unsigned c = xb_ld(&bar[XB_XCNT(j)]); sum += c; cnt += (c > 0u) ? 1u : 0u; mine = (j == x) ? c : mine; }
        if (sum == G) break;
        __builtin_amdgcn_s_sleep(1);
        if ((++sp & 255u) == 0u) { if (xb_ld(&bar[XB_TMO])) break; if (sp > XB_SPIN_CAP) { atomicAdd(&bar[XB_TMO], 1u); break; } }
    }
    nloc = mine > 0u ? mine : 1u; nx = cnt > 0u ? cnt : 1u;
}

__device__ __forceinline__ void xcd_barrier(const XcdBarrier& b) {
    asm volatile("s_waitcnt vmcnt(0)" ::: "memory");
    __syncthreads();
    if (threadIdx.x == 0) {
        unsigned* bar = b.bar;
        __builtin_amdgcn_s_waitcnt(0);
        unsigned nloc = b.st[0], nx = b.st[1];
        if (nloc == 0u) { xcd_barrier_complete(bar, b.x, nloc, nx); b.st[0] = nloc; b.st[1] = nx; }
        const unsigned old = xb_add(&bar[XB_XSUB(b.x)], 1u);
        const unsigned gen = old / nloc;
        if (old + 1u == (gen + 1u) * nloc) {
            __builtin_amdgcn_fence(__ATOMIC_RELEASE, "agent");
            asm volatile("s_waitcnt vmcnt(0)" ::: "memory");
            const unsigned og = xb_add(&bar[XB_TOP], 1u);
            const unsigned tg = og / nx;
            if (og + 1u == (tg + 1u) * nx) xb_add(&bar[XB_TOPGEN], 1u);
            else XB_SPIN(xb_ld(&bar[XB_TOPGEN]) == tg, bar);
            __builtin_amdgcn_fence(__ATOMIC_ACQUIRE, "agent");
            xb_add(&bar[XB_XGEN(b.x)], 1u);
            asm volatile("s_waitcnt vmcnt(0)" ::: "memory");
        } else {
            XB_SPIN(xb_ld(&bar[XB_XGEN(b.x)]) == gen, bar);
            __builtin_amdgcn_fence(__ATOMIC_ACQUIRE, "agent");
            asm volatile("s_waitcnt vmcnt(0)" ::: "memory");
        }
    }
    __syncthreads();
}

__global__ void __launch_bounds__(512, 2) mk_fwd(Params P) {
    extern __shared__ __attribute__((aligned(16))) unsigned char lds_raw[];
    cg::grid_group grid = cg::this_grid();
    LAS unsigned char* lds = (LAS unsigned char*)lds_raw;
    const int G = gridDim.x, bx = blockIdx.x;
    const int vcu = (G % 8 == 0) ? (bx % 8) * (G / 8) + bx / 8 : bx;
    const int NGW = G * 8;
    const float* gains = P.in[4];
    volatile LAS unsigned* bst = (volatile LAS unsigned*)(lds + LDS_BYTES - 16);
    if (threadIdx.x < 4) bst[threadIdx.x] = 0u;
    __syncthreads();
    (void)xcd_barrier_post((unsigned*)(P.ws + 65536), bst);
    int rep = 0;
#pragma nounroll
    for (int ph = 0; ph < NPH_LIMIT;) {
        if (ph == 0) phase_prologue(P, lds, vcu, NGW);
        else if (ph == 2) phase_cnorm(P, vcu, NGW);
#ifndef SKIP_MLA
        else if (ph == 4) phase_mla_attn(P, (LAS char*)lds, vcu, G);
#endif
#ifndef SKIP_DIFF
        else if (ph == 15) phase_diff_attn(P, (LAS char*)lds, vcu, G);
#endif
#ifndef SKIP_XATTN
        else if (ph == 8 || ph == 19) phase_xattn(P, ph == 8 ? 0 : 1, (LAS char*)lds, vcu, G);
#endif
        else if (ph == 6 || ph == 10 || ph == 13 || ph == 17 || ph == 21 || ph == 24) {
            const int L = ph >= 14 ? 1 : 0; const int k = (ph == 6 || ph == 17) ? 1 : (ph == 10 || ph == 21) ? 3 : 5;
            const float* ga = gains + (L * 6 + k) * DM;
            const float* gb = (k < 5) ? gains + (L * 6 + k + 1) * DM : (L == 0 ? gains + 6 * DM : nullptr);
            phase_resnorm(P, ga, gb, vcu, NGW, ph == 6);
        } else {
            GemmDesc d; const int n = gemm_desc(ph, 0, P.ws, d);
#pragma nounroll
            for (int sub = 0; sub < n; ++sub) {
                gemm_desc(ph, sub, P.ws, d);
                pg8::Gemm g{d.A, d.Bt, d.M, d.N, d.K}; pg8::StaticOrder S; S.init(d.M, d.N, G, bx);
                pg8::EpiRt E{d.C, d.mode == 2 ? 1024 : d.N, d.act, d.mode, d.C2, d.C3};
#ifndef SKIP_GEMM
                pg8::gemm_phase<pg8::EpiRt, pg8::StaticOrder, true, true>(lds, g, S, E);
#endif
                __syncthreads();
            }
        }
#define MK_XBAR() do { XcdBarrier b_; b_.bar = (unsigned*)(P.ws + 65536); b_.x = xb_xcc_id(); b_.st = (volatile LAS unsigned*)(lds + LDS_BYTES - 16); xcd_barrier(b_); } while (0)
        if (P.ws == nullptr) grid.sync();
        MK_XBAR();
#if EXTRA_SYNCS
        if (ph == 0) { for (int i = 0; i < EXTRA_SYNCS; ++i) MK_XBAR(); }
#endif
#if PROBE_SEL
        if (ph == 24 && blockIdx.x == 0 && threadIdx.x == 0) { const unsigned long long* pb = (const unsigned long long*)(P.ws + 4096); float v = 0.f;
            const int sel = PROBE_SEL;
            if (sel >= 1 && sel <= 8) { const int w = (sel - 1) >> 2, k = (sel - 1) & 3; v = (float)(unsigned)pb[w * 8 + k] / (float)(unsigned)pb[w * 8 + 4] * 0.01f; }
            else if (sel == 9) v = (float)(unsigned)(pb[18] - pb[16]) / (float)(unsigned)(pb[19] - pb[17]);
            else if (sel == 10) v = (float)(unsigned)(pb[19] - pb[17]) * 1e-4f;
            P.out[0] += v; }
#endif
        if (((REPEAT_MASK >> ph) & 1u) && rep == 0) rep = 1; else { rep = 0; ++ph; }
    }
}

extern "C" void kernel_launch(void* const* d_in, const int* in_sizes, int n_in, void* d_out, int out_size, void* d_ws, size_t ws_size, hipStream_t stream) {
    static int grid = 0;
    if (grid == 0) {
        if (n_in != 22 || out_size != MT * DM || ws_size < WS_END) {
            fprintf(stderr, "kernel_launch: unexpected shapes: n_in %d out %d ws %zu (need %zu)\n", n_in, out_size, ws_size, (size_t)WS_END); grid = -1; return; }
        int dev = 0, cus = 0, per_cu = 0;
        if (hipGetDevice(&dev) != hipSuccess || hipDeviceGetAttribute(&cus, hipDeviceAttributeMultiprocessorCount, dev) != hipSuccess) { fprintf(stderr, "kernel_launch: device query failed\n"); grid = -1; return; }
        if (hipFuncSetAttribute((const void*)mk_fwd, hipFuncAttributeMaxDynamicSharedMemorySize, LDS_BYTES) != hipSuccess) { fprintf(stderr, "kernel_launch: hipFuncSetAttribute failed\n"); grid = -1; return; }
        if (hipOccupancyMaxActiveBlocksPerMultiprocessor(&per_cu, (const void*)mk_fwd, 512, LDS_BYTES) != hipSuccess || per_cu < 1) { fprintf(stderr, "kernel_launch: occupancy query gave %d\n", per_cu); per_cu = 1; (void)hipGetLastError(); }
        grid = cus * per_cu;
    }
    if (grid < 0) return;
    if (hipMemsetAsync(d_ws, 0, 128u << 10, stream) != hipSuccess) { fprintf(stderr, "kernel_launch: hipMemsetAsync failed\n"); return; }
    Params p{};
    for (int i = 0; i < 22; ++i) p.in[i] = (const float*)d_in[i];
    p.out = (float*)d_out; p.ws = (unsigned char*)d_ws;
    void* args[] = {&p};
    hipError_t e = hipLaunchCooperativeKernel((const void*)mk_fwd, dim3(grid), dim3(512), args, LDS_BYTES, stream);
    if (e != hipSuccess) fprintf(stderr, "kernel_launch: cooperative launch failed: %s (grid %d)\n", hipGetErrorString(e), grid);
}
```
